# Optimizing an MI355X kernel written in HIP

```python
import math
import jax
import jax.numpy as jnp
from jax import lax
import numpy as np

D_MODEL = 1024
BATCH = 8
SEQ = 4096
DEPTH = 2

GRID_W = 64
CTX_LEN = 256
ROPE_THETA = 10000.0
Q_BLOCK = 128
NORM_EPS = 1e-6
L2_EPS = 1e-6

DIFF_HEADS = 4
DIFF_QK_DIM = 32
DIFF_V_DIM = 2 * DIFF_QK_DIM
DIFF_WIDTH = DIFF_HEADS * DIFF_V_DIM
GQA_Q_HEADS = 6
GQA_KV_HEADS = 2
GQA_HEAD_DIM = 64
GQA_WIDTH = GQA_Q_HEADS * GQA_HEAD_DIM
GDN_HEADS = 6
GDN_HEAD_DIM = 64
GDN_WIDTH = GDN_HEADS * GDN_HEAD_DIM
GDN_CONV = 5
GDN_CHUNK = 64

MIX_WIDTH = DIFF_WIDTH + GQA_WIDTH + GDN_WIDTH
FFN_HIDDEN = -(-(8 * D_MODEL) // (3 * 256)) * 256

IN_SPLITS = (
    DIFF_HEADS * 2 * DIFF_QK_DIM,
    DIFF_HEADS * 2 * DIFF_QK_DIM,
    DIFF_WIDTH,
    GQA_Q_HEADS * GQA_HEAD_DIM,
    GQA_KV_HEADS * GQA_HEAD_DIM,
    GQA_KV_HEADS * GQA_HEAD_DIM,
    3 * GDN_WIDTH,
    GDN_WIDTH,
    2 * GDN_HEADS,
    2 * GDN_HEADS,
)
IN_DIM = sum(IN_SPLITS)

kernel_name = "hybrid_head_group_dit"


def rms_norm(x, g):
    xf = x.astype(jnp.float32)
    y = xf * lax.rsqrt(jnp.mean(xf * xf, axis=-1, keepdims=True) + NORM_EPS)
    return (y * g.astype(jnp.float32)).astype(x.dtype)


def l2_normalize(x):
    xf = x.astype(jnp.float32)
    return xf * lax.rsqrt(jnp.sum(xf * xf, axis=-1, keepdims=True) + L2_EPS)


def modulate(h, shift, scale):
    return h * (1.0 + scale) + shift


def axial_rope_tables(rows, rot_dim):
    row = jnp.repeat(jnp.arange(rows), GRID_W).astype(jnp.float32)
    col = jnp.tile(jnp.arange(GRID_W), rows).astype(jnp.float32)
    n_freq = rot_dim // 4
    inv_freq = ROPE_THETA ** (-jnp.arange(n_freq, dtype=jnp.float32) / n_freq)
    ang = jnp.stack([row[:, None] * inv_freq, col[:, None] * inv_freq], axis=1)
    return jnp.cos(ang), jnp.sin(ang)


def apply_axial_rope(x, cos, sin):
    shp = x.shape
    nf = cos.shape[-1]
    xr = x.reshape(shp[0], shp[1], -1, 2, 2, nf).astype(jnp.float32)
    x1, x2 = xr[..., 0, :], xr[..., 1, :]
    c, s = cos[:, None], sin[:, None]
    out = jnp.stack([x1 * c - x2 * s, x2 * c + x1 * s], axis=-2)
    return out.reshape(shp).astype(x.dtype)


def sweep_query_blocks(attend, queries):
    t = queries[0].shape[1]
    nb = t // Q_BLOCK
    blocks = tuple(jnp.moveaxis(q.reshape((q.shape[0], nb, Q_BLOCK) + q.shape[2:]), 1, 0) for q in queries)
    out = lax.map(lambda qb: attend(*qb), blocks)
    out = jnp.moveaxis(out, 0, 1)
    return out.reshape((out.shape[0], t) + out.shape[3:])


def centred_depthwise_conv(x, w):
    taps = w.shape[0]
    return lax.conv_general_dilated(
        x, w[:, None, :].astype(x.dtype), window_strides=(1,),
        padding=[(taps // 2, taps // 2)], dimension_numbers=('NWC', 'WIO', 'NWC'),
        feature_group_count=x.shape[-1])


def chunked_gated_delta(q, k, v, g, beta, s0):
    bsz, t, h, dk = q.shape
    dv = v.shape[-1]
    cs = GDN_CHUNK
    n = t // cs

    def chunks(a):
        a = a.reshape((bsz, n, cs, h) + a.shape[3:])
        return jnp.moveaxis(jnp.moveaxis(a, 1, 0), 2, 3)

    qc, kc, vc, gc, bc = (chunks(a) for a in (q, k, v, g, beta))
    gcum = jnp.cumsum(gc, axis=-1)
    idx = jnp.arange(cs)
    incl = idx[:, None] >= idx[None, :]
    strict = idx[:, None] > idx[None, :]
    decay = jnp.exp(jnp.where(incl, gcum[..., :, None] - gcum[..., None, :], -jnp.inf))
    kk = jnp.einsum('nbhid,nbhjd->nbhij', kc, kc)
    a_mat = jnp.where(strict, kk * decay * bc[..., :, None], 0.0) + jnp.eye(cs, dtype=jnp.float32)
    rhs = jnp.concatenate([vc * bc[..., None], kc * (bc * jnp.exp(gcum))[..., None]], axis=-1)
    sol = lax.linalg.triangular_solve(a_mat, rhs, left_side=True, lower=True, unit_diagonal=True)
    u, w = sol[..., :dv], sol[..., dv:]
    qk = jnp.einsum('nbhid,nbhjd->nbhij', qc, kc) * decay
    q_dec = qc * jnp.exp(gcum)[..., None]
    k_dec = kc * jnp.exp(gcum[..., -1:] - gcum)[..., None]
    g_last = jnp.exp(gcum[..., -1])

    def step(state, xs):
        u_i, w_i, qk_i, qd_i, kd_i, gl_i = xs
        v_new = u_i - jnp.einsum('bhck,bhkv->bhcv', w_i, state)
        o_i = jnp.einsum('bhck,bhkv->bhcv', qd_i, state) + jnp.einsum('bhij,bhjv->bhiv', qk_i, v_new)
        state = state * gl_i[..., None, None] + jnp.einsum('bhck,bhcv->bhkv', kd_i, v_new)
        return state, o_i

    s_final, o = lax.scan(step, s0, (u, w, qk, q_dec, k_dec, g_last))
    o = jnp.moveaxis(jnp.moveaxis(o, 3, 2), 0, 1).reshape(bsz, t, h, dv)
    return o, s_final


def diff_mixer(q_l, k_l, v_l, q_c, k_c, v_c, lam_vecs, norm_g, lambda_init, cos, sin, need_ctx):
    def heads(q, k, v):
        b, t = q.shape[:2]
        return (q.reshape(b, t, DIFF_HEADS, 2, DIFF_QK_DIM),
                k.reshape(b, t, DIFF_HEADS, 2, DIFF_QK_DIM),
                v.reshape(b, t, DIFF_HEADS, DIFF_V_DIM))

    ql, kl, vl = heads(q_l, k_l, v_l)
    qc, kc, vc = heads(q_c, k_c, v_c)
    ql = apply_axial_rope(ql, cos, sin)
    kl = apply_axial_rope(kl, cos, sin)
    lf = lam_vecs.astype(jnp.float32)
    lam = jnp.exp(jnp.sum(lf[0] * lf[1])) - jnp.exp(jnp.sum(lf[2] * lf[3])) + lambda_init
    scale = DIFF_QK_DIM ** -0.5

    def attend(q, k, v):
        s = jnp.einsum('bqhcd,bkhcd->bhcqk', q, k).astype(jnp.float32) * scale
        p = jax.nn.softmax(s, axis=-1)
        p = p[:, :, 0] - lam * p[:, :, 1]
        return jnp.einsum('bhqk,bkhe->bqhe', p.astype(v.dtype), v)

    def post(o):
        b, t = o.shape[:2]
        return (rms_norm(o, norm_g) * (1.0 - lambda_init)).reshape(b, t, DIFF_WIDTH)

    k_all = jnp.concatenate([kc, kl], axis=1)
    v_all = jnp.concatenate([vc, vl], axis=1)
    y_l = post(sweep_query_blocks(lambda qb: attend(qb, k_all, v_all), (ql,)))
    y_c = post(attend(qc, kc, vc)) if need_ctx else None
    return y_l, y_c


def gqa_attend(q, k, v):
    b, tq, h, dh = q.shape
    hkv = k.shape[2]
    qg = q.reshape(b, tq, hkv, h // hkv, dh)
    s = jnp.einsum('bqhgd,bkhd->bhgqk', qg, k).astype(jnp.float32) * dh ** -0.5
    p = jax.nn.softmax(s, axis=-1)
    o = jnp.einsum('bhgqk,bkhd->bqhgd', p.astype(v.dtype), v)
    return o.reshape(b, tq, h * dh)


def gqa_mixer(q_l, k_l, v_l, q_c, k_c, v_c, qn_g, kn_g, cos, sin, need_ctx):
    def heads(q, k, v):
        b, t = q.shape[:2]
        q = rms_norm(q.reshape(b, t, GQA_Q_HEADS, GQA_HEAD_DIM), qn_g)
        k = rms_norm(k.reshape(b, t, GQA_KV_HEADS, GQA_HEAD_DIM), kn_g)
        return q, k, v.reshape(b, t, GQA_KV_HEADS, GQA_HEAD_DIM)

    ql, kl, vl = heads(q_l, k_l, v_l)
    qc, kc, vc = heads(q_c, k_c, v_c)
    ql = apply_axial_rope(ql, cos, sin)
    kl = apply_axial_rope(kl, cos, sin)
    k_all = jnp.concatenate([kc, kl], axis=1)
    v_all = jnp.concatenate([vc, vl], axis=1)
    y_l = sweep_query_blocks(lambda qb: gqa_attend(qb, k_all, v_all), (ql,))
    y_c = gqa_attend(qc, kc, vc) if need_ctx else None
    return y_l, y_c


def gdn_mixer(qkv_l, z_l, a_l, b_l, qkv_c, z_c, a_c, b_c, conv_w, a_log, dt_bias, norm_g, need_ctx):
    def prep(qkv, a, b):
        bs, t = qkv.shape[:2]
        qkv = jax.nn.silu(centred_depthwise_conv(qkv, conv_w))
        q, k, v = jnp.split(qkv, 3, axis=-1)
        q = l2_normalize(q.reshape(bs, t, GDN_HEADS, GDN_HEAD_DIM)) * GDN_HEAD_DIM ** -0.5
        k = l2_normalize(k.reshape(bs, t, GDN_HEADS, GDN_HEAD_DIM))
        v = v.reshape(bs, t, GDN_HEADS, GDN_HEAD_DIM).astype(jnp.float32)
        a = a.reshape(bs, t, 2, GDN_HEADS).astype(jnp.float32)
        b = b.reshape(bs, t, 2, GDN_HEADS).astype(jnp.float32)
        g = -jnp.exp(a_log.astype(jnp.float32)) * jax.nn.softplus(a + dt_bias.astype(jnp.float32))
        return q, k, v, g, jax.nn.sigmoid(b)

    ql, kl, vl, gl, bl = prep(qkv_l, a_l, b_l)
    qc, kc, vc, gc, bc = prep(qkv_c, a_c, b_c)
    zero = jnp.zeros((ql.shape[0], GDN_HEADS, GDN_HEAD_DIM, GDN_HEAD_DIM), jnp.float32)
    flip = lambda a: a[:, ::-1]
    oc_f, sc_f = chunked_gated_delta(qc, kc, vc, gc[:, :, 0], bc[:, :, 0], zero)
    ol_f, _ = chunked_gated_delta(ql, kl, vl, gl[:, :, 0], bl[:, :, 0], sc_f)
    oc_b, sc_b = chunked_gated_delta(flip(qc), flip(kc), flip(vc), flip(gc[:, :, 1]), flip(bc[:, :, 1]), zero)
    ol_b, _ = chunked_gated_delta(flip(ql), flip(kl), flip(vl), flip(gl[:, :, 1]), flip(bl[:, :, 1]), sc_b)

    def readout(o, z):
        bs, t = z.shape[:2]
        zh = z.reshape(bs, t, GDN_HEADS, GDN_HEAD_DIM).astype(jnp.float32)
        y = rms_norm(o, norm_g) * jax.nn.silu(zh)
        return y.reshape(bs, t, GDN_WIDTH).astype(z.dtype)

    y_l = readout(ol_f + flip(ol_b), z_l)
    y_c = readout(oc_f + flip(oc_b), z_c) if need_ctx else None
    return y_l, y_c


def swiglu(h, w_gu, w_down):
    gate, up = jnp.split(h @ w_gu, 2, axis=-1)
    return (jax.nn.silu(gate) * up) @ w_down


def setup_inputs(seed: int = 0) -> dict:
    key = jax.random.key(seed)
    ks = jax.random.split(key, 21)
    f32 = jnp.float32

    def nrm(k, shape, scale):
        return jax.random.normal(k, shape, f32) * scale

    dt = jnp.exp(jax.random.uniform(ks[14], (DEPTH, 2, GDN_HEADS), f32, math.log(1e-3), math.log(1e-1)))
    return {
        'x': nrm(ks[0], (BATCH, SEQ, D_MODEL), 1.0),
        'c': nrm(ks[1], (BATCH, D_MODEL), 1.0),
        'ctx': nrm(ks[2], (BATCH, CTX_LEN, D_MODEL), 1.0),
        'c_ctx': nrm(ks[3], (D_MODEL,), 1.0),
        'norm1_g': 1.0 + nrm(ks[4], (DEPTH, D_MODEL), 0.1),
        'ada_w': nrm(ks[5], (DEPTH, D_MODEL, 6 * D_MODEL), 0.5 * D_MODEL ** -0.5),
        'ada_b': nrm(ks[6], (DEPTH, 6 * D_MODEL), 0.02),
        'w_in': nrm(ks[7], (DEPTH, D_MODEL, IN_DIM), D_MODEL ** -0.5),
        'diff_lambda': nrm(ks[8], (DEPTH, 4, DIFF_QK_DIM), 0.1),
        'diff_norm_g': 1.0 + nrm(ks[9], (DEPTH, DIFF_V_DIM), 0.1),
        'q_norm_g': 1.0 + nrm(ks[10], (DEPTH, GQA_HEAD_DIM), 0.1),
        'k_norm_g': 1.0 + nrm(ks[11], (DEPTH, GQA_HEAD_DIM), 0.1),
        'gdn_conv_w': nrm(ks[12], (DEPTH, GDN_CONV, 3 * GDN_WIDTH), GDN_CONV ** -0.5),
        'gdn_a_log': jnp.log(jax.random.uniform(ks[13], (DEPTH, 2, GDN_HEADS), f32, 1.0, 16.0)),
        'gdn_dt_bias': dt + jnp.log(-jnp.expm1(-dt)),
        'gdn_norm_g': 1.0 + nrm(ks[15], (DEPTH, GDN_HEAD_DIM), 0.1),
        'w_out': nrm(ks[16], (DEPTH, MIX_WIDTH, D_MODEL), MIX_WIDTH ** -0.5),
        'norm2_g': 1.0 + nrm(ks[17], (DEPTH, D_MODEL), 0.1),
        'ffn_w_gu': nrm(ks[18], (DEPTH, D_MODEL, 2 * FFN_HIDDEN), D_MODEL ** -0.5),
        'ffn_w_down': nrm(ks[19], (DEPTH, FFN_HIDDEN, D_MODEL), FFN_HIDDEN ** -0.5),
        'final_norm_g': 1.0 + nrm(ks[20], (D_MODEL,), 0.1),
    }


def reference(x, c, ctx, c_ctx, norm1_g, ada_w, ada_b, w_in, diff_lambda, diff_norm_g,
              q_norm_g, k_norm_g, gdn_conv_w, gdn_a_log, gdn_dt_bias, gdn_norm_g, w_out,
              norm2_g, ffn_w_gu, ffn_w_down, final_norm_g):
    ROWS = x.shape[1] // GRID_W
    rope_diff = axial_rope_tables(ROWS, DIFF_QK_DIM)
    rope_gqa = axial_rope_tables(ROWS, GQA_HEAD_DIM)
    offs = np.cumsum(IN_SPLITS)[:-1].tolist()
    silu_c = jax.nn.silu(c)
    silu_cc = jax.nn.silu(c_ctx)
    h = x
    hc = ctx
    for layer in range(DEPTH):
        need_ctx = layer < DEPTH - 1
        lambda_init = 0.8 - 0.6 * math.exp(-0.3 * layer)
        sh1, sc1, g1, sh2, sc2, g2 = jnp.split((silu_c @ ada_w[layer] + ada_b[layer])[:, None, :], 6, axis=-1)
        csh1, csc1, cg1, csh2, csc2, cg2 = jnp.split((silu_cc @ ada_w[layer] + ada_b[layer])[None, None, :], 6, axis=-1)

        a_l = modulate(rms_norm(h, norm1_g[layer]), sh1, sc1)
        a_c = modulate(rms_norm(hc, norm1_g[layer]), csh1, csc1)
        pl = jnp.split(a_l @ w_in[layer], offs, axis=-1)
        pc = jnp.split(a_c @ w_in[layer], offs, axis=-1)
        d_l, d_c = diff_mixer(pl[0], pl[1], pl[2], pc[0], pc[1], pc[2], diff_lambda[layer],
                              diff_norm_g[layer], lambda_init, rope_diff[0], rope_diff[1], need_ctx)
        q_l, q_c = gqa_mixer(pl[3], pl[4], pl[5], pc[3], pc[4], pc[5], q_norm_g[layer], k_norm_g[layer],
                             rope_gqa[0], rope_gqa[1], need_ctx)
        n_l, n_c = gdn_mixer(pl[6], pl[7], pl[8], pl[9], pc[6], pc[7], pc[8], pc[9], gdn_conv_w[layer],
                             gdn_a_log[layer], gdn_dt_bias[layer], gdn_norm_g[layer], need_ctx)
        h = h + g1 * (jnp.concatenate([d_l, q_l, n_l], axis=-1) @ w_out[layer])
        h = h + g2 * swiglu(modulate(rms_norm(h, norm2_g[layer]), sh2, sc2), ffn_w_gu[layer], ffn_w_down[layer])
        if need_ctx:
            hc = hc + cg1 * (jnp.concatenate([d_c, q_c, n_c], axis=-1) @ w_out[layer])
            hc = hc + cg2 * swiglu(modulate(rms_norm(hc, norm2_g[layer]), csh2, csc2), ffn_w_gu[layer], ffn_w_down[layer])
    return rms_norm(h, final_norm_g)
```

```cpp
#include <hip/hip_runtime.h>
#include <hip/hip_cooperative_groups.h>
#include <cstdio>
namespace cg = cooperative_groups;

#define DI __device__ __forceinline__
typedef unsigned short bf16;
typedef __attribute__((ext_vector_type(8))) short bf16x8;
typedef __attribute__((ext_vector_type(4))) short s16x4;
typedef __attribute__((ext_vector_type(16))) float f32x16;
typedef __attribute__((ext_vector_type(4))) unsigned u32x4;
typedef __attribute__((ext_vector_type(2))) unsigned u32x2;
typedef __bf16 bf16x2_t __attribute__((ext_vector_type(2)));
typedef float f32x2_t __attribute__((ext_vector_type(2)));

constexpr int D = 1024, NB = 8, SEQ = 4096, CTXL = 256;
constexpr int NLAT = NB * SEQ, NCTX = NB * CTXL, NTOK = NLAT + NCTX;
constexpr int IN_DIM = 2968, IN_PAD = 3072, FFN = 2816;
constexpr int PA = 1408, PG = 1152, PZ = 384;
constexpr int NKEY = CTXL + SEQ;
constexpr float LOG2E = 1.4426950408889634f;
constexpr int SMEM_BYTES = 65024;
constexpr int NTHREADS = 256;
#ifndef PROBE
#define PROBE 0
#endif

struct Params {
  const float *x, *c, *ctx, *c_ctx, *norm1_g, *ada_w, *ada_b, *w_in, *diff_lambda, *diff_norm_g, *q_norm_g, *k_norm_g,
      *gdn_conv_w, *gdn_a_log, *gdn_dt_bias, *gdn_norm_g, *w_out, *norm2_g, *ffn_w_gu, *ffn_w_down, *final_norm_g;
  float* out;
  bf16 *WinT, *WoutT, *WguT, *WdT;
  float *mod, *tabD, *tabG, *hctx;
  bf16 *abuf, *projA, *projG, *projZ;
  float* ab;
  bf16 *VtD, *VtG, *gq, *gk, *U, *W;
  float* G;
  bf16* Ob;
  int* cnt;
  float* stat;
  int never;
  int pad_;
};

DI unsigned pack2(float a, float b) {
  f32x2_t v = {a, b};
  bf16x2_t r = __builtin_convertvector(v, bf16x2_t);
  return __builtin_bit_cast(unsigned, r);
}
DI bf16 f2bf(float a) { return (bf16)(pack2(a, 0.f) & 0xffffu); }
DI float bf2f(bf16 u) { return __uint_as_float(((unsigned)u) << 16); }
DI float bflo(unsigned u) { return __uint_as_float(u << 16); }
DI float bfhi(unsigned u) { return __uint_as_float(u & 0xffff0000u); }
DI f32x16 mfma32(bf16x8 a, bf16x8 b, f32x16 c) { return __builtin_amdgcn_mfma_f32_32x32x16_bf16(a, b, c, 0, 0, 0); }
DI int crow(int reg, int h) { return (reg & 3) + 8 * (reg >> 2) + 4 * h; }
DI float silu_f(float v) { return v / (1.f + __expf(-v)); }
DI float ex2(float v) { return __builtin_amdgcn_exp2f(v); }
DI f32x16 zero16() { f32x16 z;
#pragma unroll
  for (int i = 0; i < 16; ++i) z[i] = 0.f; return z; }
DI bf16x8 pack_step(const f32x16& x, int s) {
  u32x4 p;
  p[0] = pack2(x[8 * s + 0], x[8 * s + 1]);
  p[1] = pack2(x[8 * s + 2], x[8 * s + 3]);
  p[2] = pack2(x[8 * s + 4], x[8 * s + 5]);
  p[3] = pack2(x[8 * s + 6], x[8 * s + 7]);
  return __builtin_bit_cast(bf16x8, p);
}
DI bf16x8 ldfrag_perm(const bf16* row, int k0) {
  u32x2 lo = *reinterpret_cast<const u32x2*>(row + k0);
  u32x2 hi = *reinterpret_cast<const u32x2*>(row + k0 + 8);
  u32x4 p = {lo[0], lo[1], hi[0], hi[1]};
  return __builtin_bit_cast(bf16x8, p);
}
DI bf16x8 ldfrag(const bf16* p) { return *reinterpret_cast<const bf16x8*>(p); }
DI int mod_row(int tok) { return tok < NLAT ? (tok >> 12) : 8; }
DI size_t a_off(int tok, int col, int K) { return ((((size_t)(tok >> 5) * (K >> 4) + (col >> 4))) << 9) + (((col >> 3) & 1) << 8) + ((tok & 31) << 3) + (col & 7); }
DI size_t b_off(int n, int k, int K) { return ((size_t)(n >> 7) * (K >> 5) + (k >> 5)) * 4096 + (n & 127) * 32 + (k & 31); }
DI int get_tid() { int t = threadIdx.x; asm volatile("" : "+v"(t)); return t; }
DI int get_bid() { int t = blockIdx.x; asm volatile("" : "+s"(t)); return t; }


#define XB_XCNT(j) (64 * (j))
#define XB_XSUB(j) (1024 + 64 * (j))
#define XB_XGEN(j) (2048 + 64 * (j))
#define XB_TOP 3072
#define XB_TOPGEN 3136
#define XB_WORDS 3200
DI unsigned xb_ld(unsigned* q) { return __hip_atomic_load(q, __ATOMIC_RELAXED, __HIP_MEMORY_SCOPE_AGENT); }
DI unsigned xb_add(unsigned* q, unsigned v) { return __hip_atomic_fetch_add(q, v, __ATOMIC_RELAXED, __HIP_MEMORY_SCOPE_AGENT); }
DI unsigned xb_xcc_id() { return (unsigned)__builtin_amdgcn_s_getreg((3 << 11) | 20) & 0xFu; }
#define XB_SPIN(cond) do { unsigned sp_ = 0; while (cond) { __builtin_amdgcn_s_sleep(1); if (++sp_ > (1u << 22)) break; } } while (0)

DI void grid_barrier(unsigned* bar, volatile unsigned* st) {
  asm volatile("s_waitcnt vmcnt(0) lgkmcnt(0)" ::: "memory");
  __syncthreads();
  if (get_tid() == 0) {
    const unsigned x = xb_xcc_id();
    unsigned nloc = st[0], nx = st[1];
    if (nloc == 0u) {
      const unsigned G = gridDim.x;
      unsigned sp = 0;
      for (;;) {
        unsigned sum = 0, cnt = 0, mine = 0;
        for (unsigned j = 0; j < 16; ++j) { const unsigned c = xb_ld(&bar[XB_XCNT(j)]); sum += c; cnt += (c > 0u) ? 1u : 0u; mine = (j == x) ? c : mine; }
        nloc = mine > 0u ? mine : 1u; nx = cnt > 0u ? cnt : 1u;
        if (sum == G) break;
        __builtin_amdgcn_s_sleep(1);
        if (++sp > (1u << 22)) break;
      }
      st[0] = nloc; st[1] = nx;
    }
    const unsigned old = xb_add(&bar[XB_XSUB(x)], 1u);
    const unsigned gen = old / nloc;
    if (old + 1u == (gen + 1u) * nloc) {
      __builtin_amdgcn_fence(__ATOMIC_RELEASE, "agent");
      asm volatile("s_waitcnt vmcnt(0)" ::: "memory");
      const unsigned og = xb_add(&bar[XB_TOP], 1u);
      const unsigned tg = og / nx;
      if (og + 1u == (tg + 1u) * nx) xb_add(&bar[XB_TOPGEN], 1u);
      else XB_SPIN(xb_ld(&bar[XB_TOPGEN]) == tg);
      __builtin_amdgcn_fence(__ATOMIC_ACQUIRE, "agent");
      xb_add(&bar[XB_XGEN(x)], 1u);
      asm volatile("s_waitcnt vmcnt(0)" ::: "memory");
    } else {
      XB_SPIN(xb_ld(&bar[XB_XGEN(x)]) == gen);
      __builtin_amdgcn_fence(__ATOMIC_ACQUIRE, "agent");
      asm volatile("s_waitcnt vmcnt(0)" ::: "memory");
    }
  }
  __syncthreads();
}

DI void sincos_d(double a, double& s, double& c) {
  double kq = rint(a * 0.63661977236758134308);
  double r = a - kq * 1.57079632679489661923;
  double r2 = r * r;
  double sp = r * (1.0 + r2 * (-1.0 / 6 + r2 * (1.0 / 120 + r2 * (-1.0 / 5040 + r2 * (1.0 / 362880 + r2 * (-1.0 / 39916800 + r2 * (1.0 / 6227020800.0)))))));
  double cp = 1.0 + r2 * (-0.5 + r2 * (1.0 / 24 + r2 * (-1.0 / 720 + r2 * (1.0 / 40320 + r2 * (-1.0 / 3628800 + r2 * (1.0 / 479001600.0 + r2 * (-1.0 / 87178291200.0)))))));
  int q = ((int)kq) & 3;
  if (q == 0) { s = sp; c = cp; }
  else if (q == 1) { s = cp; c = -sp; }
  else if (q == 2) { s = -sp; c = -cp; }
  else { s = -cp; c = sp; }
}

DI void ada_item(const Params& p, int it, char* smem) {
  const int tid = get_tid();
  const int l = it / 96, n0 = (it % 96) * 64;
  float* sc = (float*)smem;
  float* red = (float*)(smem + 36864);
  for (int i = tid; i < 9216; i += NTHREADS) {
    int r = i >> 10, k = i & 1023;
    float v = r < 8 ? p.c[r * 1024 + k] : p.c_ctx[k];
    sc[i] = silu_f(v);
  }
  __syncthreads();
  const int col = tid & 63, ks = tid >> 6;
  float acc[9];
#pragma unroll
  for (int r = 0; r < 9; ++r) acc[r] = 0.f;
  const float* wp = p.ada_w + ((size_t)l * 1024 + ks * 256) * 6144 + n0 + col;
  for (int k = 0; k < 256; k += 32) {
    float w[32];
#pragma unroll
    for (int u = 0; u < 32; ++u) w[u] = wp[(size_t)(k + u) * 6144];
#pragma unroll
    for (int u = 0; u < 32; ++u)
#pragma unroll
      for (int r = 0; r < 9; ++r) acc[r] += sc[r * 1024 + ks * 256 + k + u] * w[u];
  }
#pragma unroll
  for (int r = 0; r < 9; ++r) red[(ks * 9 + r) * 64 + col] = acc[r];
  __syncthreads();
  for (int i = tid; i < 576; i += NTHREADS) {
    int r = i >> 6, cc = i & 63;
    float s = red[(0 * 9 + r) * 64 + cc] + red[(1 * 9 + r) * 64 + cc] + red[(2 * 9 + r) * 64 + cc] + red[(3 * 9 + r) * 64 + cc];
    int n = n0 + cc;
    p.mod[(size_t)(l * 9 + r) * 6144 + n] = s + p.ada_b[l * 6144 + n];
  }
  __syncthreads();
}

DI void table_item(const Params& p) {
  const int tid = get_tid();
  for (int i = tid; i < 64 * 8; i += NTHREADS) {
    int pos = i >> 3, f = i & 7;
    float inv = ex2(-(float)f * (13.287712379549449f / 8.f));
    float ang = (float)pos * inv;
    double s, c; sincos_d((double)ang, s, c);
    p.tabD[2 * i] = (float)c; p.tabD[2 * i + 1] = (float)s;
  }
  for (int i = tid; i < 64 * 16; i += NTHREADS) {
    int pos = i >> 4, f = i & 15;
    float inv = ex2(-(float)f * (13.287712379549449f / 16.f));
    float ang = (float)pos * inv;
    double s, c; sincos_d((double)ang, s, c);
    p.tabG[2 * i] = (float)c; p.tabG[2 * i + 1] = (float)s;
  }
}

DI void wconv_tile(const float* src, int ld, bf16* dst, int K, int k0, int n0, int mode, char* smem) {
  const int tid = get_tid();
  float* tile = (float*)smem;
  {
    const int c = tid & 63, r0 = tid >> 6;
    const int n = n0 + c;
    int col;
    if (mode == 0) col = n < IN_DIM ? n : -1;
    else if (mode == 2) col = ((n >> 5) & 1) * FFN + (n >> 7) * 64 + ((n >> 6) & 1) * 32 + (n & 31);
    else col = n;
    float v[16];
#pragma unroll
    for (int i = 0; i < 16; ++i) v[i] = col >= 0 ? src[(size_t)(k0 + r0 * 16 + i) * ld + col] : 0.f;
#pragma unroll
    for (int i = 0; i < 16; ++i) tile[(r0 * 16 + i) * 65 + c] = v[i];
  }
  __syncthreads();
  {
    const int nn = tid >> 2, kseg = (tid & 3) * 16;
    unsigned w[8];
#pragma unroll
    for (int j = 0; j < 8; ++j) w[j] = pack2(tile[(kseg + 2 * j) * 65 + nn], tile[(kseg + 2 * j + 1) * 65 + nn]);
    u32x4* d = reinterpret_cast<u32x4*>(dst + b_off(n0 + nn, k0 + kseg, K));
    u32x4 a = {w[0], w[1], w[2], w[3]}, b = {w[4], w[5], w[6], w[7]};
    d[0] = a; d[1] = b;
  }
  __syncthreads();
}

DI void phase0(const Params& p, char* smem) {
  if (blockIdx.x == 0 && threadIdx.x < 16) p.cnt[threadIdx.x] = 0;
  constexpr int T_IN = 16 * 48, T_OUT = 16 * 16, T_GU = 16 * 88, T_DN = 44 * 16, T_L = T_IN + T_OUT + T_GU + T_DN;
  const int total = 193 + 2 * T_L;
  for (int it = blockIdx.x; it < total; it += gridDim.x) {
    if (it < 192) { ada_item(p, it, smem); continue; }
    if (it == 192) { table_item(p); continue; }
    int t = it - 193;
    int l = t / T_L; t -= l * T_L;
    if (t < T_IN) { int kt = t / 48, nt = t % 48;
      wconv_tile(p.w_in + (size_t)l * 1024 * IN_DIM, IN_DIM, p.WinT + (size_t)l * IN_PAD * 1024, 1024, kt * 64, nt * 64, 0, smem); continue; }
    t -= T_IN;
    if (t < T_OUT) { int kt = t / 16, nt = t % 16;
      wconv_tile(p.w_out + (size_t)l * 1024 * 1024, 1024, p.WoutT + (size_t)l * 1024 * 1024, 1024, kt * 64, nt * 64, 1, smem); continue; }
    t -= T_OUT;
    if (t < T_GU) { int kt = t / 88, nt = t % 88;
      wconv_tile(p.ffn_w_gu + (size_t)l * 1024 * 2 * FFN, 2 * FFN, p.WguT + (size_t)l * 2 * FFN * 1024, 1024, kt * 64, nt * 64, 2, smem); continue; }
    t -= T_GU;
    { int kt = t / 16, nt = t % 16;
      wconv_tile(p.ffn_w_down + (size_t)l * FFN * 1024, 1024, p.WdT + (size_t)l * 1024 * FFN, FFN, kt * 64, nt * 64, 1, smem); }
  }
}

DI void prep_phase(const Params& p, const float* hlat, const float* hctx, const float* g, const float* modl, int wsh, int wsc, int M) {
  const int tid = get_tid(), wave = tid >> 6, lane = tid & 63;
  for (int tok0 = get_bid() * 8 + wave * 2; tok0 < M; tok0 += gridDim.x * 8) {
    float4 v[2][4];
    float ss[2] = {0.f, 0.f};
#pragma unroll
    for (int rr = 0; rr < 2; ++rr) {
      const int tok = tok0 + rr;
      const float* row = tok < NLAT ? hlat + (size_t)tok * D : hctx + (size_t)(tok - NLAT) * D;
#pragma unroll
      for (int i = 0; i < 4; ++i) v[rr][i] = *reinterpret_cast<const float4*>(row + i * 256 + lane * 4);
    }
#pragma unroll
    for (int rr = 0; rr < 2; ++rr)
#pragma unroll
      for (int i = 0; i < 4; ++i) ss[rr] += v[rr][i].x * v[rr][i].x + v[rr][i].y * v[rr][i].y + v[rr][i].z * v[rr][i].z + v[rr][i].w * v[rr][i].w;
#pragma unroll
    for (int o = 32; o >= 1; o >>= 1) { ss[0] += __shfl_xor(ss[0], o); ss[1] += __shfl_xor(ss[1], o); }
#pragma unroll
    for (int rr = 0; rr < 2; ++rr) {
      const int tok = tok0 + rr;
      const float rstd = rsqrtf(ss[rr] * (1.f / D) + 1e-6f);
      const float* mr = modl + (size_t)mod_row(tok) * 6144;
#pragma unroll
      for (int i = 0; i < 4; ++i) {
        int col = i * 256 + lane * 4;
        float4 gg = *reinterpret_cast<const float4*>(g + col);
        float4 sh = *reinterpret_cast<const float4*>(mr + wsh * 1024 + col);
        float4 sc = *reinterpret_cast<const float4*>(mr + wsc * 1024 + col);
        float a0 = v[rr][i].x * rstd * gg.x * (1.f + sc.x) + sh.x;
        float a1 = v[rr][i].y * rstd * gg.y * (1.f + sc.y) + sh.y;
        float a2 = v[rr][i].z * rstd * gg.z * (1.f + sc.z) + sh.z;
        float a3 = v[rr][i].w * rstd * gg.w * (1.f + sc.w) + sh.w;
        u32x2 o = {pack2(a0, a1), pack2(a2, a3)};
        *reinterpret_cast<u32x2*>(p.abuf + a_off(tok, col, D)) = o;
      }
    }
  }
}

enum { EPI_PROJ = 0, EPI_RES = 1, EPI_SWIGLU = 2 };
struct EpiArgs {
  const float* hin_lat; const float* hin_ctx; float* hout_lat; float* hout_ctx; const float* gate;
};

template <int EPI>
DI void gemm_tile(const Params& p, const bf16* A, int lda, const bf16* Bt, int K, int mt, int nt, const EpiArgs& ea, char* smem) {
  constexpr int LS = 40, STG = 128 * LS;
  bf16* Sm = (bf16*)smem;
  const int tid = get_tid(), wave = tid >> 6, lane = tid & 63, l31 = lane & 31, hh = lane >> 5;
  const int m0 = mt * 256, n0 = nt * 128;
  f32x16 acc[2][4];
#pragma unroll
  for (int i = 0; i < 2; ++i)
#pragma unroll
    for (int j = 0; j < 4; ++j) acc[i][j] = zero16();
  const int nk = K / 32, kb16 = K >> 4;
  bf16x8 af[2][2][2];
  u32x4 rb[2][2];
  const bf16* Ag = A + (((size_t)(mt * 8 + wave * 2) * kb16) << 9) + hh * 256 + l31 * 8;
  const int lrow = tid >> 2, lcc = tid & 3;
  const bf16* Bg = Bt + (size_t)nt * (K >> 5) * 4096 + lrow * 32 + lcc * 8;
  auto gloadA = [&](bf16x8 (*f)[2], int kt) {
    const int k2 = min(kt, nk - 1) * 2;
#pragma unroll
    for (int s2 = 0; s2 < 2; ++s2)
#pragma unroll
      for (int i = 0; i < 2; ++i) f[s2][i] = *reinterpret_cast<const bf16x8*>(Ag + (((size_t)i * kb16 + k2 + s2) << 9));
  };
  auto gloadB = [&](u32x4* r, int kt) {
    const int k = min(kt, nk - 1);
#pragma unroll
    for (int i = 0; i < 2; ++i) r[i] = *reinterpret_cast<const u32x4*>(Bg + (size_t)k * 4096 + i * 2048);
  };
  auto lstoreB = [&](const u32x4* r, int buf) {
    bf16* d = Sm + buf * STG + lrow * LS + lcc * 8;
#pragma unroll
    for (int i = 0; i < 2; ++i) *reinterpret_cast<u32x4*>(d + i * 64 * LS) = r[i];
  };
  auto compute = [&](bf16x8 (*f)[2], int buf) {
    const bf16* Bb = Sm + buf * STG + l31 * LS + hh * 8;
    bf16x8 bfr[2][4];
#pragma unroll
    for (int s2 = 0; s2 < 2; ++s2)
#pragma unroll
      for (int j = 0; j < 4; ++j) bfr[s2][j] = ldfrag(Bb + j * 32 * LS + s2 * 16);
#pragma unroll
    for (int s2 = 0; s2 < 2; ++s2)
#pragma unroll
      for (int i = 0; i < 2; ++i)
#pragma unroll
        for (int j = 0; j < 4; ++j) acc[i][j] = mfma32(f[s2][i], bfr[s2][j], acc[i][j]);
  };
  gloadA(af[0], 0);
  gloadA(af[1], 1);
  gloadB(rb[0], 0);
  gloadB(rb[1], 1);
  lstoreB(rb[0], 0);
  __syncthreads();
  for (int kt = 0; kt < nk; kt += 2) {
    gloadB(rb[0], kt + 2);
    __builtin_amdgcn_sched_barrier(0);
    compute(af[0], 0);
    gloadA(af[0], kt + 2);
    lstoreB(rb[1], 1);
    __syncthreads();
    gloadB(rb[1], kt + 3);
    __builtin_amdgcn_sched_barrier(0);
    compute(af[1], 1);
    gloadA(af[1], kt + 3);
    lstoreB(rb[0], 0);
    __syncthreads();
  }
  {
    char* slab = smem + wave * 9216;
    if (EPI == EPI_PROJ && nt == 23) {
#pragma unroll
      for (int i = 0; i < 2; ++i)
#pragma unroll
        for (int r = 0; r < 16; ++r) {
          const int tok = m0 + wave * 64 + i * 32 + crow(r, hh);
          if (l31 < 24) p.ab[(size_t)tok * 24 + l31] = acc[i][0][r];
        }
    } else if (EPI == EPI_PROJ || EPI == EPI_SWIGLU) {
      bf16* stg = (bf16*)slab;
#pragma unroll
      for (int jh = 0; jh < 2; ++jh) {
#pragma unroll
        for (int ii = 0; ii < 2; ++ii)
#pragma unroll
          for (int r = 0; r < 16; ++r) {
            const int row = ii * 32 + crow(r, hh);
            if (EPI == EPI_PROJ) {
              stg[row * 72 + l31] = f2bf(acc[ii][2 * jh][r]);
              stg[row * 72 + 32 + l31] = f2bf(acc[ii][2 * jh + 1][r]);
            } else {
              stg[row * 72 + l31] = f2bf(silu_f(acc[ii][2 * jh][r]) * acc[ii][2 * jh + 1][r]);
            }
          }
        asm volatile("s_waitcnt lgkmcnt(0)" ::: "memory");
        if (EPI == EPI_PROJ) {
#pragma unroll
          for (int q = 0; q < 8; ++q) {
            const int idx = q * 64 + lane, row = idx >> 3, seg = idx & 7;
            const u32x4 v = *reinterpret_cast<const u32x4*>(stg + row * 72 + seg * 8);
            const int tok = m0 + wave * 64 + row;
            const int cidx = n0 + jh * 64 + seg * 8;
            bf16* dst;
            if (nt < 11) dst = p.projA + (size_t)tok * PA + cidx;
            else if (nt < 20) dst = p.projG + (size_t)tok * PG + (cidx - PA);
            else dst = p.projZ + (size_t)tok * PZ + (cidx - PA - PG);
            *reinterpret_cast<u32x4*>(dst) = v;
          }
        } else {
#pragma unroll
          for (int q = 0; q < 4; ++q) {
            const int idx = q * 64 + lane, row = idx >> 2, seg = idx & 3;
            const u32x4 v = *reinterpret_cast<const u32x4*>(stg + row * 72 + seg * 8);
            const int tok = m0 + wave * 64 + row;
            *reinterpret_cast<u32x4*>(p.projA + a_off(tok, nt * 64 + jh * 32 + seg * 8, FFN)) = v;
          }
        }
        asm volatile("s_waitcnt lgkmcnt(0)" ::: "memory");
      }
    } else {
      float* stg = (float*)slab;
#pragma unroll
      for (int i = 0; i < 2; ++i)
#pragma unroll
        for (int jh = 0; jh < 2; ++jh) {
#pragma unroll
          for (int r = 0; r < 16; ++r) {
            stg[crow(r, hh) * 68 + l31] = acc[i][2 * jh][r];
            stg[crow(r, hh) * 68 + 32 + l31] = acc[i][2 * jh + 1][r];
          }
          asm volatile("s_waitcnt lgkmcnt(0)" ::: "memory");
#pragma unroll
          for (int q = 0; q < 8; ++q) {
            const int idx = q * 64 + lane, row = idx >> 4, seg = idx & 15;
            const float4 a = *reinterpret_cast<const float4*>(stg + row * 68 + seg * 4);
            const int tok = m0 + wave * 64 + i * 32 + row;
            const int cidx = n0 + jh * 64 + seg * 4;
            const float* hin = tok < NLAT ? ea.hin_lat + (size_t)tok * D : ea.hin_ctx + (size_t)(tok - NLAT) * D;
            float* hout = tok < NLAT ? ea.hout_lat + (size_t)tok * D : ea.hout_ctx + (size_t)(tok - NLAT) * D;
            const float4 hv = *reinterpret_cast<const float4*>(hin + cidx);
            const float4 gt = *reinterpret_cast<const float4*>(ea.gate + (size_t)mod_row(tok) * 6144 + cidx);
            float4 o = {hv.x + gt.x * a.x, hv.y + gt.y * a.y, hv.z + gt.z * a.z, hv.w + gt.w * a.w};
            *reinterpret_cast<float4*>(hout + cidx) = o;
          }
          asm volatile("s_waitcnt lgkmcnt(0)" ::: "memory");
        }
    }
    __syncthreads();
  }
}

template <int EPI>
DI void gemm_phase(const Params& p, const bf16* A, int lda, const bf16* Bt, int M, int N, int K, const EpiArgs& ea, char* smem) {
  const int ntm = M / 256, ntn = N / 128;
  const int bid = get_bid();
  const int x = bid & 7, j = bid >> 3, nloc = gridDim.x >> 3;
  const int R = ntm >> 3;
  for (int u = j; u < R * ntn; u += nloc) {
    const int rg = u / (8 * ntn), rem = u - rg * 8 * ntn;
    const int gs = min(8, R - rg * 8);
    const int nt = rem / gs, r = rem - nt * gs;
    const int mt = x * R + rg * 8 + r;
    gemm_tile<EPI>(p, A, lda, Bt, K, mt, nt, ea, smem);
  }
}

DI void tokblock_info(int tb, int& tok0, int& seq_tok0, int& t0, int& seqlen, int& b, int& isctx) {
  if (tb < 512) { b = tb >> 6; t0 = (tb & 63) * 64; seq_tok0 = b * SEQ; seqlen = SEQ; isctx = 0; }
  else { int u = tb - 512; b = u >> 2; t0 = (u & 3) * 64; seq_tok0 = NLAT + b * CTXL; seqlen = CTXL; isctx = 1; }
  tok0 = seq_tok0 + t0;
}

DI void headvec_unit(const Params& p, int l, int u, int item) {
  const int tok = u >> 4, hu = u & 15;
  int col0;
  if (hu < 4) col0 = hu * 64; else if (hu < 8) col0 = 256 + (hu - 4) * 64; else if (hu < 14) col0 = 768 + (hu - 8) * 64; else col0 = 1152 + (hu - 14) * 64;
  bf16* ptr = p.projA + (size_t)tok * PA + col0;
  float x[64];
#pragma unroll
  for (int i = 0; i < 8; ++i) {
    u32x4 v = reinterpret_cast<const u32x4*>(ptr)[i];
#pragma unroll
    for (int j = 0; j < 4; ++j) { x[i * 8 + 2 * j] = bflo(v[j]); x[i * 8 + 2 * j + 1] = bfhi(v[j]); }
  }
  const bool lat = tok < NLAT;
  const int t = tok & (SEQ - 1);
  const int prow = t >> 6, pcol = t & 63;
  float scale = 1.f;
  if (hu < 8) {
    if (lat) {
#pragma unroll
      for (int comp = 0; comp < 2; ++comp)
#pragma unroll
        for (int ax = 0; ax < 2; ++ax) {
          const float* tb = p.tabD + (ax == 0 ? prow : pcol) * 16;
#pragma unroll
          for (int f = 0; f < 8; ++f) {
            float c = tb[2 * f], s = tb[2 * f + 1];
            float x1 = x[comp * 32 + ax * 16 + f], x2 = x[comp * 32 + ax * 16 + 8 + f];
            x[comp * 32 + ax * 16 + f] = x1 * c - x2 * s;
            x[comp * 32 + ax * 16 + 8 + f] = x2 * c + x1 * s;
          }
        }
    }
    if (hu < 4) scale = 0.17677669529663687f * LOG2E;
  } else {
    float ss = 0.f;
#pragma unroll
    for (int i = 0; i < 64; ++i) ss += x[i] * x[i];
    const float r = rsqrtf(ss * (1.f / 64.f) + 1e-6f);
    const float* g = (hu < 14 ? p.q_norm_g : p.k_norm_g) + l * 64;
#pragma unroll
    for (int i = 0; i < 64; ++i) x[i] = x[i] * r * g[i];
    if (lat) {
#pragma unroll
      for (int ax = 0; ax < 2; ++ax) {
        const float* tb = p.tabG + (ax == 0 ? prow : pcol) * 32;
#pragma unroll
        for (int f = 0; f < 16; ++f) {
          float c = tb[2 * f], s = tb[2 * f + 1];
          float x1 = x[ax * 32 + f], x2 = x[ax * 32 + 16 + f];
          x[ax * 32 + f] = x1 * c - x2 * s;
          x[ax * 32 + 16 + f] = x2 * c + x1 * s;
        }
      }
    }
    if (hu < 14) scale = 0.125f * LOG2E;
  }
  float nrm2 = 0.f;
#pragma unroll
  for (int i = 0; i < 8; ++i) {
    u32x4 v;
#pragma unroll
    for (int j = 0; j < 4; ++j) {
      const float a0 = x[i * 8 + 2 * j] * scale, a1 = x[i * 8 + 2 * j + 1] * scale;
      nrm2 += a0 * a0 + a1 * a1;
      v[j] = pack2(a0, a1);
    }
    reinterpret_cast<u32x4*>(ptr)[i] = v;
  }
  float mq = hu < 4 ? nrm2 : 0.f, mk = (hu >= 4 && hu < 8) ? nrm2 : 0.f;
#pragma unroll
  for (int o = 32; o >= 1; o >>= 1) { mq = fmaxf(mq, __shfl_xor(mq, o)); mk = fmaxf(mk, __shfl_xor(mk, o)); }
  const int tid = get_tid();
  if ((tid & 63) == 0) {
    float* st = p.stat + ((size_t)l * 8704 + item * 4 + (tid >> 6)) * 2;
    st[0] = mq; st[1] = mk;
  }
}

DI void vtrans_item(const Params& p, int it, char* smem) {
  const int tid = get_tid();
  const int tb = it / 6, vh = it % 6;
  int tok0, seq_tok0, t0, seqlen, b, isctx;
  tokblock_info(tb, tok0, seq_tok0, t0, seqlen, b, isctx);
  bf16* tile = (bf16*)smem;
  const int col0 = vh < 4 ? 512 + vh * 64 : 1280 + (vh - 4) * 64;
  {
    const int row = tid >> 2, seg = tid & 3;
    const u32x4* src = reinterpret_cast<const u32x4*>(p.projA + (size_t)(tok0 + row) * PA + col0 + seg * 16);
    u32x4 a = src[0], c = src[1];
    unsigned* d = reinterpret_cast<unsigned*>(tile + row * 66 + seg * 16);
    d[0] = a[0]; d[1] = a[1]; d[2] = a[2]; d[3] = a[3]; d[4] = c[0]; d[5] = c[1]; d[6] = c[2]; d[7] = c[3];
  }
  __syncthreads();
  {
    const int dv = tid >> 2, kseg = (tid & 3) * 16;
    unsigned w[8];
#pragma unroll
    for (int j = 0; j < 8; ++j) w[j] = (unsigned)tile[(kseg + 2 * j) * 66 + dv] | ((unsigned)tile[(kseg + 2 * j + 1) * 66 + dv] << 16);
    bf16* dstbase = vh < 4 ? p.VtD + ((size_t)(b * 4 + vh) * 64 + dv) * NKEY : p.VtG + ((size_t)(b * 2 + vh - 4) * 64 + dv) * NKEY;
    const int key0 = (isctx ? 0 : CTXL) + t0 + kseg;
    u32x4 a = {w[0], w[1], w[2], w[3]}, c = {w[4], w[5], w[6], w[7]};
    reinterpret_cast<u32x4*>(dstbase + key0)[0] = a;
    reinterpret_cast<u32x4*>(dstbase + key0)[1] = c;
  }
  __syncthreads();
}

template <int S>
DI void gdn_diag_block2(f32x16& R0, f32x16& R1, const bf16* nL0, const bf16* nL1, int rowbase, int hh) {
#pragma unroll
  for (int rho = 0; rho < 16; ++rho) {
    const int ho = (rho >> 2) & 1, qo = (rho & 3) + 4 * (rho >> 3);
    const float own0 = R0[8 * S + qo], own1 = R1[8 * S + qo];
    const float oth0 = __shfl_xor(own0, 32), oth1 = __shfl_xor(own1, 32);
    const float x0 = (hh == ho) ? own0 : oth0, x1 = (hh == ho) ? own1 : oth1;
#pragma unroll
    for (int q = 0; q < 8; ++q) {
      const int rmax = (q & 3) + 8 * (q >> 2) + 4;
      if (rmax > rho) {
        const int rp = (q & 3) + 8 * (q >> 2) + 4 * hh;
        const int o = (rowbase + rp) * 72 + rowbase + rho;
        R0[8 * S + q] += bf2f(nL0[o]) * x0;
        R1[8 * S + q] += bf2f(nL1[o]) * x1;
      }
    }
  }
}

DI void gdn_local_item(const Params& p, int l, int it, char* smem) {
  const int tid = get_tid(), wave = tid >> 6, lane = tid & 63, l31 = lane & 31, hh = lane >> 5;
  const int tb = it / 6, h = it % 6;
  int tok0, seq_tok0, t0, seqlen, b, isctx;
  tokblock_info(tb, tok0, seq_tok0, t0, seqlen, b, isctx);
  float* tmp = (float*)smem;
  float* vf = tmp + 64 * 65;
  bf16* kb = (bf16*)(vf + 64 * 65);
  bf16* nL = kb + 64 * 72;
  float* gsm = (float*)(nL + 2 * 64 * 72);
  float* bs = gsm; float* Gs = gsm + 128; float* rn = gsm + 256;
  const int cp = tid & 31, seg = tid >> 5;
  unsigned xin[3][12];
#pragma unroll
  for (int m = 0; m < 3; ++m)
#pragma unroll
    for (int r = 0; r < 12; ++r) {
      const int sidx = t0 + seg * 8 + r - 2;
      unsigned v = 0;
      if (sidx >= 0 && sidx < seqlen) v = *reinterpret_cast<const unsigned*>(p.projG + (size_t)(seq_tok0 + sidx) * PG + m * 384 + h * 64 + 2 * cp);
      xin[m][r] = v;
    }
  if (tid < 128) {
    const int dir = tid >> 6, i = lane;
    const float* abp = p.ab + (size_t)(tok0 + i) * 24;
    const float a = abp[dir * 6 + h], bb = abp[12 + dir * 6 + h];
    const float z = a + p.gdn_dt_bias[l * 12 + dir * 6 + h];
    const float e = __expf(-fabsf(z));
    const float l1p = e < 1e-2f ? e * (1.f - e * (0.5f - e * (1.f / 3.f))) : __logf(1.f + e);
    const float sp = fmaxf(z, 0.f) + l1p;
    const float g = -__expf(p.gdn_a_log[l * 12 + dir * 6 + h]) * sp;
    const float beta = 1.f / (1.f + __expf(-bb));
    float cs = g;
    if (dir == 0) {
#pragma unroll
      for (int o = 1; o < 64; o <<= 1) { float t = __shfl_up(cs, o); if (i >= o) cs += t; }
    } else {
#pragma unroll
      for (int o = 1; o < 64; o <<= 1) { float t = __shfl_down(cs, o); if (i + o < 64) cs += t; }
    }
    bs[dir * 64 + i] = beta; Gs[dir * 64 + i] = cs;
    p.G[((size_t)dir * NTOK + tok0 + i) * 6 + h] = cs;
  }
#pragma unroll
  for (int m = 0; m < 3; ++m) {
    float* dst = m == 2 ? vf : tmp;
    const float* cw = p.gdn_conv_w + (size_t)l * 5 * PG + m * 384 + h * 64 + 2 * cp;
    float w0[5], w1[5];
#pragma unroll
    for (int j = 0; j < 5; ++j) { w0[j] = cw[j * PG]; w1[j] = cw[j * PG + 1]; }
#pragma unroll
    for (int r = 0; r < 8; ++r) {
      float a0 = 0.f, a1 = 0.f;
#pragma unroll
      for (int j = 0; j < 5; ++j) { a0 += w0[j] * bflo(xin[m][r + j]); a1 += w1[j] * bfhi(xin[m][r + j]); }
      dst[(seg * 8 + r) * 65 + 2 * cp] = silu_f(a0);
      dst[(seg * 8 + r) * 65 + 2 * cp + 1] = silu_f(a1);
    }
    __syncthreads();
    if (m < 2) {
      {
        const int row = tid >> 2, qt = tid & 3;
        float ss = 0.f;
#pragma unroll
        for (int c = 0; c < 16; ++c) { float v = tmp[row * 65 + qt * 16 + c]; ss += v * v; }
        ss += __shfl_xor(ss, 1); ss += __shfl_xor(ss, 2);
        if (qt == 0) rn[row] = rsqrtf(ss + 1e-6f) * (m == 0 ? 0.125f : 1.f);
      }
      __syncthreads();
      bf16* gdst = (m == 0 ? p.gq : p.gk) + (size_t)tok0 * 384 + h * 64;
      for (int idx = tid; idx < 2048; idx += NTHREADS) {
        const int tau = idx >> 5, c = (idx & 31) * 2;
        const float r = rn[tau];
        unsigned w = pack2(tmp[tau * 65 + c] * r, tmp[tau * 65 + c + 1] * r);
        *reinterpret_cast<unsigned*>(gdst + (size_t)tau * 384 + c) = w;
        if (m == 1) *reinterpret_cast<unsigned*>(kb + tau * 72 + c) = w;
      }
      __syncthreads();
    }
  }
  {
    const int dk = tid >> 2, i0 = (tid & 3) * 16;
    unsigned w[8];
#pragma unroll
    for (int e = 0; e < 8; ++e) w[e] = (unsigned)kb[(i0 + 2 * e) * 72 + dk] | ((unsigned)kb[(i0 + 2 * e + 1) * 72 + dk] << 16);
    bf16* kt = p.abuf + (((size_t)((tok0 >> 6) * 2 + h / 3) * 64 + 40) << 9) + (h % 3) * 4096 + dk * 64 + i0;
    const u32x4 a = {w[0], w[1], w[2], w[3]}, c2 = {w[4], w[5], w[6], w[7]};
    reinterpret_cast<u32x4*>(kt)[0] = a; reinterpret_cast<u32x4*>(kt)[1] = c2;
  }
  {
    const int wi = wave >> 1, wj = wave & 1;
    f32x16 kk = zero16();
#pragma unroll
    for (int s = 0; s < 4; ++s) {
      bf16x8 a = ldfrag(kb + (32 * wi + l31) * 72 + 16 * s + 8 * hh);
      bf16x8 bq = ldfrag(kb + (32 * wj + l31) * 72 + 16 * s + 8 * hh);
      kk = mfma32(a, bq, kk);
    }
    const int j = 32 * wj + l31;
    const float G0j = Gs[j], G1j = Gs[64 + j];
#pragma unroll
    for (int r = 0; r < 16; ++r) {
      const int i = 32 * wi + crow(r, hh);
      const float v0 = kk[r] * __expf(Gs[i] - G0j) * bs[i];
      const float v1 = kk[r] * __expf(Gs[64 + i] - G1j) * bs[64 + i];
      nL[i * 72 + j] = f2bf(i > j ? -v0 : 0.f);
      nL[64 * 72 + (63 - i) * 72 + (63 - j)] = f2bf(i < j ? -v1 : 0.f);
    }
  }
  __syncthreads();
  {
    const bf16* nL0 = nL; const bf16* nL1 = nL + 64 * 72;
    f32x16 R0[2], R1[2];
#pragma unroll
    for (int t = 0; t < 2; ++t)
#pragma unroll
      for (int r = 0; r < 16; ++r) {
        const int fi = 32 * t + crow(r, hh);
        const int i1 = 63 - fi;
        float v0, v1;
        if (wave < 2) { v0 = vf[fi * 65 + 32 * wave + l31] * bs[fi]; v1 = vf[i1 * 65 + 32 * wave + l31] * bs[64 + i1]; }
        else {
          v0 = bf2f(kb[fi * 72 + 32 * (wave - 2) + l31]) * bs[fi] * __expf(Gs[fi]);
          v1 = bf2f(kb[i1 * 72 + 32 * (wave - 2) + l31]) * bs[64 + i1] * __expf(Gs[64 + i1]);
        }
        R0[t][r] = v0; R1[t][r] = v1;
      }
    const bf16x8 z8 = {0, 0, 0, 0, 0, 0, 0, 0};
    gdn_diag_block2<0>(R0[0], R1[0], nL0, nL1, 0, hh);
    {
      bf16x8 xb0 = pack_step(R0[0], 0), xb1 = pack_step(R1[0], 0);
      bf16x8 a00 = ldfrag_perm(nL0 + l31 * 72, 4 * hh), a10 = ldfrag_perm(nL1 + l31 * 72, 4 * hh);
      if (l31 < 16) { a00 = z8; a10 = z8; }
      R0[0] = mfma32(a00, xb0, R0[0]); R1[0] = mfma32(a10, xb1, R1[0]);
      R0[1] = mfma32(ldfrag_perm(nL0 + (32 + l31) * 72, 4 * hh), xb0, R0[1]);
      R1[1] = mfma32(ldfrag_perm(nL1 + (32 + l31) * 72, 4 * hh), xb1, R1[1]);
    }
    gdn_diag_block2<1>(R0[0], R1[0], nL0, nL1, 16, hh);
    {
      bf16x8 xb0 = pack_step(R0[0], 1), xb1 = pack_step(R1[0], 1);
      R0[1] = mfma32(ldfrag_perm(nL0 + (32 + l31) * 72, 16 + 4 * hh), xb0, R0[1]);
      R1[1] = mfma32(ldfrag_perm(nL1 + (32 + l31) * 72, 16 + 4 * hh), xb1, R1[1]);
    }
    gdn_diag_block2<0>(R0[1], R1[1], nL0, nL1, 32, hh);
    {
      bf16x8 xb0 = pack_step(R0[1], 0), xb1 = pack_step(R1[1], 0);
      bf16x8 a01 = ldfrag_perm(nL0 + (32 + l31) * 72, 32 + 4 * hh), a11 = ldfrag_perm(nL1 + (32 + l31) * 72, 32 + 4 * hh);
      if (l31 < 16) { a01 = z8; a11 = z8; }
      R0[1] = mfma32(a01, xb0, R0[1]); R1[1] = mfma32(a11, xb1, R1[1]);
    }
    gdn_diag_block2<1>(R0[1], R1[1], nL0, nL1, 48, hh);
    {
      const size_t cbase = (size_t)h * 64 + 32 * (wave & 1) + l31;
      bf16* ob0 = (wave < 2 ? p.U : p.W) + (size_t)tok0 * 384 + cbase;
      bf16* ob1 = (wave < 2 ? p.U : p.W) + ((size_t)NTOK + tok0) * 384 + cbase;
#pragma unroll
      for (int t = 0; t < 2; ++t)
#pragma unroll
        for (int r = 0; r < 16; ++r) {
          const int fi = 32 * t + crow(r, hh);
          ob0[(size_t)fi * 384] = f2bf(wave < 2 ? R0[t][r] : -R0[t][r]);
          ob1[(size_t)(63 - fi) * 384] = f2bf(wave < 2 ? R1[t][r] : -R1[t][r]);
        }
    }
  }
  __syncthreads();
}

DI void gdn_scan_item(const Params& p, int it, char* smem) {
  const int tid = get_tid(), wave = tid >> 6, lane = tid & 63, l31 = lane & 31, hh = lane >> 5;
  const int b = it / 12, h = (it % 12) >> 1, dir = it & 1;
  constexpr int LS = 72;
  bf16* Qr = (bf16*)smem; bf16* Kr = Qr + 64 * LS; bf16* nW = Kr + 64 * LS; bf16* Qd = nW + 64 * LS;
  bf16* QK = Qd + 64 * LS; bf16* KdT = QK + 64 * LS; bf16* Ub = KdT + 64 * LS;
  float* Gs = (float*)(Ub + 64 * LS);
  f32x16 S[2];
  S[0] = zero16(); S[1] = zero16();
  const bf16* Ud = p.U + (size_t)dir * NTOK * 384;
  const bf16* Wd = p.W + (size_t)dir * NTOK * 384;
  const float* Gd = p.G + (size_t)dir * NTOK * 6;
  bf16* Od = p.Ob + (size_t)dir * NTOK * 384;
  for (int ci = 0; ci < 68; ++ci) {
    int tok0;
    if (ci < 4) tok0 = NLAT + b * CTXL + (dir ? 3 - ci : ci) * 64;
    else tok0 = b * SEQ + (dir ? 67 - ci : ci - 4) * 64;
    const float gtot = Gd[(size_t)(tok0 + (dir ? 0 : 63)) * 6 + h];
#pragma unroll
    for (int ii = 0; ii < 2; ++ii) {
      const int cidx = tid + ii * 256, row = cidx >> 3, cc = cidx & 7;
      const size_t off = (size_t)(tok0 + row) * 384 + h * 64 + cc * 8;
      const u32x4 q = *reinterpret_cast<const u32x4*>(p.gq + off);
      const u32x4 k = *reinterpret_cast<const u32x4*>(p.gk + off);
      const u32x4 w = *reinterpret_cast<const u32x4*>(Wd + off);
      const u32x4 u = *reinterpret_cast<const u32x4*>(Ud + off);
      const float Gi = Gd[(size_t)(tok0 + row) * 6 + h];
      const float eq = __expf(Gi), ek = __expf(gtot - Gi);
      const int lo = row * LS + cc * 8;
      *reinterpret_cast<u32x4*>(Qr + lo) = q;
      *reinterpret_cast<u32x4*>(Kr + lo) = k;
      *reinterpret_cast<u32x4*>(Ub + lo) = u;
      u32x4 nw, qd;
#pragma unroll
      for (int j = 0; j < 4; ++j) {
        nw[j] = w[j] ^ 0x80008000u;
        qd[j] = pack2(bflo(q[j]) * eq, bfhi(q[j]) * eq);
        KdT[(cc * 8 + 2 * j) * LS + row] = f2bf(bflo(k[j]) * ek);
        KdT[(cc * 8 + 2 * j + 1) * LS + row] = f2bf(bfhi(k[j]) * ek);
      }
      *reinterpret_cast<u32x4*>(nW + lo) = nw;
      *reinterpret_cast<u32x4*>(Qd + lo) = qd;
      if (cc == 0) Gs[row] = Gi;
    }
    __syncthreads();
    {
      const int wi = wave >> 1, wj = wave & 1;
      f32x16 acc = zero16();
#pragma unroll
      for (int s = 0; s < 4; ++s) {
        bf16x8 a = ldfrag(Qr + (32 * wi + l31) * LS + 16 * s + 8 * hh);
        bf16x8 bq = ldfrag(Kr + (32 * wj + l31) * LS + 16 * s + 8 * hh);
        acc = mfma32(a, bq, acc);
      }
      const int j = 32 * wj + l31;
      const float Gj = Gs[j];
#pragma unroll
      for (int r = 0; r < 16; ++r) {
        const int i = 32 * wi + crow(r, hh);
        const bool ok = dir ? (i <= j) : (i >= j);
        const float v = acc[r] * __expf(Gs[i] - Gj);
        QK[i * LS + j] = f2bf(ok ? v : 0.f);
      }
    }
    __syncthreads();
    if (wave < 2) {
      const int c = wave;
      const float glast = __expf(gtot);
      bf16x8 Sf[2][2];
#pragma unroll
      for (int a = 0; a < 2; ++a)
#pragma unroll
        for (int s = 0; s < 2; ++s) Sf[a][s] = pack_step(S[a], s);
      f32x16 vn[2], o[2];
#pragma unroll
      for (int r = 0; r < 2; ++r) {
#pragma unroll
        for (int reg = 0; reg < 16; ++reg) vn[r][reg] = bf2f(Ub[(32 * r + crow(reg, hh)) * LS + 32 * c + l31]);
        o[r] = zero16();
#pragma unroll
        for (int a = 0; a < 2; ++a)
#pragma unroll
          for (int s = 0; s < 2; ++s) {
            const int k0 = 32 * a + 16 * s + 4 * hh;
            vn[r] = mfma32(ldfrag_perm(nW + (32 * r + l31) * LS, k0), Sf[a][s], vn[r]);
            o[r] = mfma32(ldfrag_perm(Qd + (32 * r + l31) * LS, k0), Sf[a][s], o[r]);
          }
      }
      bf16x8 Vf[2][2];
#pragma unroll
      for (int r = 0; r < 2; ++r)
#pragma unroll
        for (int s = 0; s < 2; ++s) Vf[r][s] = pack_step(vn[r], s);
#pragma unroll
      for (int a = 0; a < 2; ++a) {
#pragma unroll
        for (int reg = 0; reg < 16; ++reg) S[a][reg] *= glast;
      }
#pragma unroll
      for (int r2 = 0; r2 < 2; ++r2)
#pragma unroll
        for (int s = 0; s < 2; ++s) {
          const int k0 = 32 * r2 + 16 * s + 4 * hh;
#pragma unroll
          for (int r = 0; r < 2; ++r) o[r] = mfma32(ldfrag_perm(QK + (32 * r + l31) * LS, k0), Vf[r2][s], o[r]);
#pragma unroll
          for (int a = 0; a < 2; ++a) S[a] = mfma32(ldfrag_perm(KdT + (32 * a + l31) * LS, k0), Vf[r2][s], S[a]);
        }
#pragma unroll
      for (int r = 0; r < 2; ++r)
#pragma unroll
        for (int reg = 0; reg < 16; ++reg)
          Od[(size_t)(tok0 + 32 * r + crow(reg, hh)) * 384 + h * 64 + 32 * c + l31] = f2bf(o[r][reg]);
    }
    __syncthreads();
  }
}

DI bf16x8 gfrag_perm(const bf16* row, int k0) {
  u32x2 lo = *reinterpret_cast<const u32x2*>(row + k0);
  u32x2 hi = *reinterpret_cast<const u32x2*>(row + k0 + 8);
  u32x4 q = {lo[0], lo[1], hi[0], hi[1]};
  return __builtin_bit_cast(bf16x8, q);
}
DI void gdn_scan_item2(const Params& p, int b, int h, int dir, char* smem) {
  constexpr int LS = 72, TS = 64 * LS;
  bf16* Tu = (bf16*)smem; bf16* Tw = Tu + TS; bf16* Tq = Tw + TS; bf16* Tk = Tq + TS; bf16* TkT = Tk + TS;
  float* Gs = (float*)(TkT + TS);
  bf16x8* MAs = reinterpret_cast<bf16x8*>(Gs + 64);
  const int wave = __builtin_amdgcn_readfirstlane(get_tid() >> 6);
  const bool loader = wave >= 2;
  const int c = wave & 1;
  const bf16* Ud = p.U + (size_t)dir * NTOK * 384;
  const bf16* Wd = p.W + (size_t)dir * NTOK * 384;
  const float* Gd = p.G + (size_t)dir * NTOK * 6;
  bf16* Od = p.Ob + (size_t)dir * NTOK * 384;
  auto chunk_tok0 = [&](int ci) {
    return ci < 4 ? NLAT + b * CTXL + (dir ? 3 - ci : ci) * 64 : b * SEQ + (dir ? 67 - ci : ci - 4) * 64;
  };
  u32x4 ld[5][4];
  float ldg = 0.f;
  auto lload = [&](int ci) {
    const int lt = get_tid() & 127;
    const int t0 = chunk_tok0(ci);
    const bf16* kts = p.abuf + (((size_t)((t0 >> 6) * 2 + h / 3) * 64 + 40) << 9) + (h % 3) * 4096;
#pragma unroll
    for (int i = 0; i < 4; ++i) {
      const int cidx = lt + i * 128, row = cidx >> 3, cc = cidx & 7;
      const size_t off = (size_t)(t0 + row) * 384 + h * 64 + cc * 8;
      ld[0][i] = *reinterpret_cast<const u32x4*>(Ud + off);
      ld[1][i] = *reinterpret_cast<const u32x4*>(Wd + off);
      ld[2][i] = *reinterpret_cast<const u32x4*>(p.gq + off);
      ld[3][i] = *reinterpret_cast<const u32x4*>(p.gk + off);
      ld[4][i] = *reinterpret_cast<const u32x4*>(kts + row * 64 + cc * 8);
    }
    if (lt < 64) ldg = Gd[(size_t)(t0 + lt) * 6 + h];
  };
  auto lstore = [&]() {
    const int lt = get_tid() & 127;
#pragma unroll
    for (int i = 0; i < 4; ++i) {
      const int cidx = lt + i * 128, row = cidx >> 3, cc = cidx & 7;
#pragma unroll
      for (int t = 0; t < 5; ++t) *reinterpret_cast<u32x4*>(Tu + t * TS + row * LS + cc * 8) = ld[t][i];
    }
    if (lt < 64) Gs[lt] = ldg;
  };
  if (loader) {
    lload(0); lstore();
    __syncthreads();
#pragma unroll 1
    for (int ci = 0; ci < 68; ++ci) {
      if (ci < 67) lload(ci + 1);
      {
        const int tid = get_tid(), lane = tid & 63, l31 = lane & 31, hh = lane >> 5;
        const float Gc0 = Gs[l31], Gc1 = Gs[32 + l31];
#pragma unroll
        for (int t = 0; t < 3; ++t) {
          if ((t == 2) != (wave == 3)) continue;
          const int jb = t == 0 ? 0 : (t == 2 ? 1 : dir), ib = t == 0 ? 0 : (t == 2 ? 1 : 1 - dir);
          f32x16 m = zero16();
#pragma unroll
          for (int s2 = 0; s2 < 4; ++s2)
            m = mfma32(ldfrag(Tk + (32 * jb + l31) * LS + 16 * s2 + 8 * hh), ldfrag(Tq + (32 * ib + l31) * LS + 16 * s2 + 8 * hh), m);
          const float Gi = ib ? Gc1 : Gc0;
#pragma unroll
          for (int reg = 0; reg < 16; ++reg) {
            const float Gj = Gs[32 * jb + crow(reg, hh)];
            float v = m[reg] * __expf(Gi - Gj);
            if (t != 1) {
              const int jl = crow(reg, hh);
              const bool keep = dir ? (l31 <= jl) : (l31 >= jl);
              v = keep ? v : 0.f;
            }
            m[reg] = v;
          }
          MAs[(t * 2 + 0) * 64 + lane] = pack_step(m, 0);
          MAs[(t * 2 + 1) * 64 + lane] = pack_step(m, 1);
        }
      }
      __syncthreads();
      __syncthreads();
      if (ci < 67) lstore();
      __syncthreads();
    }
    return;
  }
  f32x16 S[2];
  S[0] = zero16(); S[1] = zero16();
  __syncthreads();
#pragma unroll 1
  for (int ci = 0; ci < 68; ++ci) {
    {
      const int tid = get_tid(), lane = tid & 63, l31 = lane & 31, hh = lane >> 5;
      const int tok0 = chunk_tok0(ci);
      const float gtot = Gs[dir ? 0 : 63];
      bf16x8 Vf[2][2];
      f32x16 o[2];
      {
        bf16x8 Sf[2][2];
#pragma unroll
        for (int a = 0; a < 2; ++a)
#pragma unroll
          for (int s2 = 0; s2 < 2; ++s2) Sf[a][s2] = pack_step(S[a], s2);
        const float glast = __expf(gtot);
#pragma unroll
        for (int a = 0; a < 2; ++a)
#pragma unroll
          for (int reg = 0; reg < 16; ++reg) S[a][reg] *= glast;
#pragma unroll
        for (int r = 0; r < 2; ++r) {
          f32x16 vn;
#pragma unroll
          for (int reg = 0; reg < 16; ++reg) vn[reg] = bf2f(Tu[(32 * r + crow(reg, hh)) * LS + 32 * c + l31]);
          o[r] = zero16();
#pragma unroll
          for (int a = 0; a < 2; ++a)
#pragma unroll
            for (int s2 = 0; s2 < 2; ++s2) {
              const int k0 = 32 * a + 16 * s2 + 4 * hh;
              vn = mfma32(ldfrag_perm(Tw + (32 * r + l31) * LS, k0), Sf[a][s2], vn);
              o[r] = mfma32(ldfrag_perm(Tq + (32 * r + l31) * LS, k0), Sf[a][s2], o[r]);
            }
          Vf[r][0] = pack_step(vn, 0); Vf[r][1] = pack_step(vn, 1);
          f32x16 vs;
#pragma unroll
          for (int reg = 0; reg < 16; ++reg) {
            const float Gi = Gs[32 * r + crow(reg, hh)];
            o[r][reg] *= __expf(Gi);
            vs[reg] = vn[reg] * __expf(gtot - Gi);
          }
          const bf16x8 vk0 = pack_step(vs, 0), vk1 = pack_step(vs, 1);
#pragma unroll
          for (int a = 0; a < 2; ++a) {
            S[a] = mfma32(ldfrag_perm(TkT + (32 * a + l31) * LS, 32 * r + 4 * hh), vk0, S[a]);
            S[a] = mfma32(ldfrag_perm(TkT + (32 * a + l31) * LS, 32 * r + 16 + 4 * hh), vk1, S[a]);
          }
        }
      }
      __syncthreads();
#pragma unroll
      for (int s2 = 0; s2 < 2; ++s2) {
        o[0] = mfma32(MAs[(0 * 2 + s2) * 64 + lane], Vf[0][s2], o[0]);
        o[1] = mfma32(MAs[(2 * 2 + s2) * 64 + lane], Vf[1][s2], o[1]);
        if (dir == 0) o[1] = mfma32(MAs[(1 * 2 + s2) * 64 + lane], Vf[0][s2], o[1]);
        else o[0] = mfma32(MAs[(1 * 2 + s2) * 64 + lane], Vf[1][s2], o[0]);
      }
#pragma unroll
      for (int r = 0; r < 2; ++r)
#pragma unroll
        for (int reg = 0; reg < 16; ++reg)
          Od[(size_t)(tok0 + 32 * r + crow(reg, hh)) * 384 + h * 64 + 32 * c + l31] = f2bf(o[r][reg]);
    }
    __syncthreads();
    __syncthreads();
  }
}

template <int NC, bool NOMAX>
DI void attn_item(const Params& p, int l, int b, int head, int qb, int isctx, char* smem) {
  const int tid = get_tid(), wave = tid >> 6, lane = tid & 63, l31 = lane & 31, hh = lane >> 5;
  constexpr int KS = 72, VS = 68;
  bf16* Ks = (bf16*)smem;
  bf16* Vs = Ks + 2 * 64 * KS;
  const int kvh = NC == 1 ? head / 3 : head;
  const int qcol0 = NC == 1 ? 768 + head * 64 : head * 64;
  const int kcol0 = NC == 1 ? 1152 + kvh * 64 : 256 + head * 64;
  const int ocol0 = NC == 1 ? 256 + head * 64 : head * 64;
  const bf16* Vt = NC == 1 ? p.VtG + (size_t)(b * 2 + kvh) * 64 * NKEY : p.VtD + (size_t)(b * 4 + head) * 64 * NKEY;
  const int tokq0 = isctx ? NLAT + b * CTXL + qb * 128 : b * SEQ + qb * 128;
  const int nkt = isctx ? 4 : 68;
  bf16x8 qf[4];
  {
    const bf16* qp = p.projA + (size_t)(tokq0 + wave * 32 + l31) * PA + qcol0 + 8 * hh;
#pragma unroll
    for (int s = 0; s < 4; ++s) qf[s] = *reinterpret_cast<const bf16x8*>(qp + 16 * s);
  }
  u32x4 rk[2], rv[2];
  auto gload = [&](int kt) {
    const int ktok0 = kt < 4 ? NLAT + b * CTXL + kt * 64 : b * SEQ + (kt - 4) * 64;
#pragma unroll
    for (int ii = 0; ii < 2; ++ii) {
      const int cidx = tid + ii * 256, row = cidx >> 3, cc = cidx & 7;
      rk[ii] = *reinterpret_cast<const u32x4*>(p.projA + (size_t)(ktok0 + row) * PA + kcol0 + cc * 8);
      rv[ii] = *reinterpret_cast<const u32x4*>(Vt + (size_t)row * NKEY + kt * 64 + cc * 8);
    }
  };
  auto lstore = [&](int buf) {
#pragma unroll
    for (int ii = 0; ii < 2; ++ii) {
      const int cidx = tid + ii * 256, row = cidx >> 3, cc = cidx & 7;
      *reinterpret_cast<u32x4*>(Ks + (buf * 64 + row) * KS + cc * 8) = rk[ii];
      u32x2 lo = {rv[ii][0], rv[ii][1]}, hi = {rv[ii][2], rv[ii][3]};
      *reinterpret_cast<u32x2*>(Vs + (buf * 64 + row) * VS + cc * 8) = lo;
      *reinterpret_cast<u32x2*>(Vs + (buf * 64 + row) * VS + cc * 8 + 4) = hi;
    }
  };
  f32x16 O[NC][2];
  float mrun[NC], lrun[NC];
#pragma unroll
  for (int c = 0; c < NC; ++c) { O[c][0] = zero16(); O[c][1] = zero16(); mrun[c] = -1e30f; lrun[c] = 0.f; }
  gload(0);
  lstore(0);
  __syncthreads();
  auto tile_body = [&](int kt) {
    const int buf = kt & 1;
    if (kt + 1 < nkt) gload(kt + 1);
    bf16x8 pf[NC][2][2];
#pragma unroll
    for (int c = 0; c < NC; ++c) {
      f32x16 S[2];
#pragma unroll
      for (int sub = 0; sub < 2; ++sub) {
        S[sub] = zero16();
        const bf16* kp = Ks + (buf * 64 + 32 * sub + l31) * KS + 8 * hh;
        if (NC == 2) {
#pragma unroll
          for (int s = 0; s < 2; ++s) S[sub] = mfma32(ldfrag(kp + 32 * c + 16 * s), qf[2 * c + s], S[sub]);
        } else {
#pragma unroll
          for (int s = 0; s < 4; ++s) S[sub] = mfma32(ldfrag(kp + 16 * s), qf[s], S[sub]);
        }
      }
      if (NOMAX) {
        float ls = 0.f;
#pragma unroll
        for (int sub = 0; sub < 2; ++sub)
#pragma unroll
          for (int r = 0; r < 16; ++r) { float e = ex2(S[sub][r]); S[sub][r] = e; ls += e; }
        lrun[c] += ls;
      } else {
        float mx = S[0][0];
#pragma unroll
        for (int r = 0; r < 16; ++r) { mx = fmaxf(mx, S[0][r]); mx = fmaxf(mx, S[1][r]); }
        mx = fmaxf(mx, __shfl_xor(mx, 32));
        const float mnew = fmaxf(mrun[c], mx);
        const float alpha = ex2(mrun[c] - mnew);
        mrun[c] = mnew;
        float ls = 0.f;
#pragma unroll
        for (int sub = 0; sub < 2; ++sub)
#pragma unroll
          for (int r = 0; r < 16; ++r) { float e = ex2(S[sub][r] - mnew); S[sub][r] = e; ls += e; }
        lrun[c] = lrun[c] * alpha + ls;
#pragma unroll
        for (int r = 0; r < 16; ++r) { O[c][0][r] *= alpha; O[c][1][r] *= alpha; }
      }
#pragma unroll
      for (int sub = 0; sub < 2; ++sub)
#pragma unroll
        for (int s2 = 0; s2 < 2; ++s2) pf[c][sub][s2] = pack_step(S[sub], s2);
    }
#pragma unroll
    for (int sub = 0; sub < 2; ++sub)
#pragma unroll
      for (int s2 = 0; s2 < 2; ++s2) {
        const int k0 = 32 * sub + 16 * s2 + 4 * hh;
        bf16x8 v0 = ldfrag_perm(Vs + (buf * 64 + l31) * VS, k0);
        bf16x8 v1 = ldfrag_perm(Vs + (buf * 64 + 32 + l31) * VS, k0);
#pragma unroll
        for (int c = 0; c < NC; ++c) {
          O[c][0] = mfma32(v0, pf[c][sub][s2], O[c][0]);
          O[c][1] = mfma32(v1, pf[c][sub][s2], O[c][1]);
        }
      }
    __builtin_amdgcn_sched_barrier(0);
    if (kt + 1 < nkt) lstore(buf ^ 1);
    __syncthreads();
  };
  if (NC == 2) {
#pragma unroll 1
    for (int kt = 0; kt < nkt; ++kt) tile_body(kt);
  } else {
    for (int kt = 0; kt < nkt; ++kt) tile_body(kt);
  }
  const int tid2 = get_tid(), hh2 = (tid2 >> 5) & 1;
  const int tok = tokq0 + (tid2 >> 6) * 32 + (tid2 & 31);
  bf16* op = p.abuf;
  if (NC == 1) {
    const float inv = 1.f / (lrun[0] + __shfl_xor(lrun[0], 32));
#pragma unroll
    for (int dvt = 0; dvt < 2; ++dvt)
#pragma unroll
      for (int g = 0; g < 4; ++g) {
        u32x2 w = {pack2(O[0][dvt][4 * g] * inv, O[0][dvt][4 * g + 1] * inv), pack2(O[0][dvt][4 * g + 2] * inv, O[0][dvt][4 * g + 3] * inv)};
        *reinterpret_cast<u32x2*>(op + a_off(tok, ocol0 + 32 * dvt + 8 * g + 4 * hh2, D)) = w;
      }
  } else {
    const float* lf = p.diff_lambda + l * 128;
    float s01 = 0.f, s23 = 0.f;
    for (int i = 0; i < 32; ++i) { s01 += lf[i] * lf[32 + i]; s23 += lf[64 + i] * lf[96 + i]; }
    const float lam_init = 0.8f - 0.6f * __expf(-0.3f * (float)l);
    const float lam = __expf(s01) - __expf(s23) + lam_init;
    const float inv0 = 1.f / (lrun[0] + __shfl_xor(lrun[0], 32));
    const float inv1 = lam / (lrun[NC - 1] + __shfl_xor(lrun[NC - 1], 32));
    float ss = 0.f;
#pragma unroll
    for (int dvt = 0; dvt < 2; ++dvt)
#pragma unroll
      for (int r = 0; r < 16; ++r) { float v = O[0][dvt][r] * inv0 - O[NC - 1][dvt][r] * inv1; O[0][dvt][r] = v; ss += v * v; }
    ss += __shfl_xor(ss, 32);
    const float rs = rsqrtf(ss * (1.f / 64.f) + 1e-6f) * (1.f - lam_init);
    const float* gn = p.diff_norm_g + l * 64;
#pragma unroll
    for (int dvt = 0; dvt < 2; ++dvt)
#pragma unroll
      for (int g = 0; g < 4; ++g) {
        const int dv0 = 32 * dvt + 8 * g + 4 * hh2;
        u32x2 w = {pack2(O[0][dvt][4 * g] * rs * gn[dv0], O[0][dvt][4 * g + 1] * rs * gn[dv0 + 1]),
                   pack2(O[0][dvt][4 * g + 2] * rs * gn[dv0 + 2], O[0][dvt][4 * g + 3] * rs * gn[dv0 + 3])};
        *reinterpret_cast<u32x2*>(op + a_off(tok, ocol0 + dv0, D)) = w;
      }
  }
}

DI void readout_phase(const Params& p, int l, int M) {
  const int total = M * 6;
  for (int u = get_bid() * NTHREADS + get_tid(); u < total; u += gridDim.x * NTHREADS) {
    const int tok = u / 6, h = u % 6;
    const u32x4* of = reinterpret_cast<const u32x4*>(p.Ob + (size_t)tok * 384 + h * 64);
    const u32x4* ob = reinterpret_cast<const u32x4*>(p.Ob + ((size_t)NTOK + tok) * 384 + h * 64);
    const u32x4* zp = reinterpret_cast<const u32x4*>(p.projZ + (size_t)tok * PZ + h * 64);
    bf16* op = p.abuf;
    const float* g = p.gdn_norm_g + l * 64;
    float x[64];
    float ss = 0.f;
#pragma unroll
    for (int i = 0; i < 8; ++i) {
      u32x4 a = of[i], c = ob[i];
#pragma unroll
      for (int j = 0; j < 4; ++j) {
        float v0 = bflo(a[j]) + bflo(c[j]), v1 = bfhi(a[j]) + bfhi(c[j]);
        x[i * 8 + 2 * j] = v0; x[i * 8 + 2 * j + 1] = v1; ss += v0 * v0 + v1 * v1;
      }
    }
    const float r = rsqrtf(ss * (1.f / 64.f) + 1e-6f);
#pragma unroll
    for (int i = 0; i < 8; ++i) {
      u32x4 z = zp[i], w;
#pragma unroll
      for (int j = 0; j < 4; ++j) {
        float y0 = x[i * 8 + 2 * j] * r * g[i * 8 + 2 * j] * silu_f(bflo(z[j]));
        float y1 = x[i * 8 + 2 * j + 1] * r * g[i * 8 + 2 * j + 1] * silu_f(bfhi(z[j]));
        w[j] = pack2(y0, y1);
      }
      *reinterpret_cast<u32x4*>(op + a_off(tok, 640 + h * 64 + 8 * i, D)) = w;
    }
  }
}

DI void final_phase(const Params& p) {
  const int tid = get_tid(), wave = tid >> 6, lane = tid & 63;
  for (int tok0 = get_bid() * 8 + wave * 2; tok0 < NLAT; tok0 += gridDim.x * 8) {
    float4 v[2][4];
    float ss[2] = {0.f, 0.f};
#pragma unroll
    for (int rr = 0; rr < 2; ++rr)
#pragma unroll
      for (int i = 0; i < 4; ++i) v[rr][i] = *reinterpret_cast<const float4*>(p.out + (size_t)(tok0 + rr) * D + i * 256 + lane * 4);
#pragma unroll
    for (int rr = 0; rr < 2; ++rr)
#pragma unroll
      for (int i = 0; i < 4; ++i) ss[rr] += v[rr][i].x * v[rr][i].x + v[rr][i].y * v[rr][i].y + v[rr][i].z * v[rr][i].z + v[rr][i].w * v[rr][i].w;
#pragma unroll
    for (int o = 32; o >= 1; o >>= 1) { ss[0] += __shfl_xor(ss[0], o); ss[1] += __shfl_xor(ss[1], o); }
#pragma unroll
    for (int rr = 0; rr < 2; ++rr) {
      const float rstd = rsqrtf(ss[rr] * (1.f / D) + 1e-6f);
#pragma unroll
      for (int i = 0; i < 4; ++i) {
        int col = i * 256 + lane * 4;
        float4 gg = *reinterpret_cast<const float4*>(p.final_norm_g + col);
        float4 o = {v[rr][i].x * rstd * gg.x, v[rr][i].y * rstd * gg.y, v[rr][i].z * rstd * gg.z, v[rr][i].w * rstd * gg.w};
        *reinterpret_cast<float4*>(p.out + (size_t)(tok0 + rr) * D + col) = o;
      }
    }
  }
}

DI void phaseC(const Params& p, int l, char* smem, bool skip_hv = false) {
  constexpr int N_GDN = 544 * 6, N_VT = 544 * 6;
  constexpr int N_HV = (NTOK * 16) / NTHREADS;
  const int total = N_GDN + N_VT + N_HV;
  for (int it = get_bid(); it < total; it += gridDim.x) {
    if (it < N_GDN) gdn_local_item(p, l, it, smem);
    else if (it < N_GDN + N_VT) vtrans_item(p, it - N_GDN, smem);
    else if (!skip_hv) headvec_unit(p, l, (it - N_GDN - N_VT) * NTHREADS + get_tid(), it - N_GDN - N_VT);
  }
}

DI void phaseD(const Params& p, int l, char* smem, int ci) {
  __shared__ int s_item;
  const int b = get_bid() & 7;
  const int n_scan = 12, n_diff = 4 * 32, n_gqa = 6 * 32;
  const int n_cd = l == 0 ? 4 * 2 : 0, n_cg = l == 0 ? 6 * 2 : 0;
  const int total = n_scan + n_diff + n_gqa + n_cd + n_cg;
  float gqm = 0.f, gkm = 0.f;
  for (int i = 0; i < 64; ++i) { gqm = fmaxf(gqm, fabsf(p.q_norm_g[l * 64 + i])); gkm = fmaxf(gkm, fabsf(p.k_norm_g[l * 64 + i])); }
  const bool fast_g = 64.f * 0.125f * LOG2E * gqm * gkm * 1.02f < 100.f;
  __shared__ float s_red[8];
  bool fast_d;
  {
    const int tid = get_tid();
    const float* st = p.stat + (size_t)l * 8704 * 2;
    float mq = 0.f, mk = 0.f;
    for (int i = tid; i < 8704; i += NTHREADS) { mq = fmaxf(mq, st[2 * i]); mk = fmaxf(mk, st[2 * i + 1]); }
#pragma unroll
    for (int o = 32; o >= 1; o >>= 1) { mq = fmaxf(mq, __shfl_xor(mq, o)); mk = fmaxf(mk, __shfl_xor(mk, o)); }
    __syncthreads();
    if ((tid & 63) == 0) { s_red[(tid >> 6) * 2] = mq; s_red[(tid >> 6) * 2 + 1] = mk; }
    __syncthreads();
    mq = fmaxf(fmaxf(s_red[0], s_red[2]), fmaxf(s_red[4], s_red[6]));
    mk = fmaxf(fmaxf(s_red[1], s_red[3]), fmaxf(s_red[5], s_red[7]));
    fast_d = sqrtf(mq * mk) * 1.02f < 100.f;
  }
  for (;;) {
    __syncthreads();
    if (get_tid() == 0) s_item = atomicAdd(&p.cnt[ci * 8 + b], 1);
    __syncthreads();
    int it = s_item;
    if (it >= total) break;
    if (it < n_scan) { gdn_scan_item2(p, b, it >> 1, it & 1, smem); continue; }
    it -= n_scan;
    if (it < n_diff) { if (fast_d) attn_item<2, true>(p, l, b, it >> 5, it & 31, 0, smem); else attn_item<2, false>(p, l, b, it >> 5, it & 31, 0, smem); continue; }
    it -= n_diff;
    if (it < n_gqa) { if (fast_g) attn_item<1, true>(p, l, b, it >> 5, it & 31, 0, smem); else attn_item<1, false>(p, l, b, it >> 5, it & 31, 0, smem); continue; }
    it -= n_gqa;
    if (it < n_cd) { if (fast_d) attn_item<2, true>(p, l, b, it >> 1, it & 1, 1, smem); else attn_item<2, false>(p, l, b, it >> 1, it & 1, 1, smem); continue; }
    it -= n_cd;
    if (fast_g) attn_item<1, true>(p, l, b, it >> 1, it & 1, 1, smem); else attn_item<1, false>(p, l, b, it >> 1, it & 1, 1, smem);
  }
}

__global__ void __launch_bounds__(NTHREADS, 2) mega_kernel(Params p) {
  __shared__ __attribute__((aligned(16))) char smem[SMEM_BYTES];
  cg::grid_group grid = cg::this_grid();
  unsigned* bar = reinterpret_cast<unsigned*>(p.cnt) + 64;
  __shared__ unsigned xb_state[4];
  volatile unsigned* xst = xb_state;
  if (threadIdx.x == 0) { xb_state[0] = 0u; xb_state[1] = 0u; xb_add(&bar[XB_XCNT(xb_xcc_id())], 1u); }
  phase0(p, smem);
  if (p.never) grid.sync();
  grid_barrier(bar, xst);
#pragma unroll 1
  for (int l = 0; l < 2; ++l) {
    const float* hlat = l == 0 ? p.x : p.out;
    const float* hctx = l == 0 ? p.ctx : p.hctx;
    const float* modl = p.mod + (size_t)l * 9 * 6144;
    const int Mfull = NTOK;
    const int Mout = l == 0 ? NTOK : NLAT;
    EpiArgs ea{};
    prep_phase(p, hlat, hctx, p.norm1_g + l * D, modl, 0, 1, Mfull);
    grid_barrier(bar, xst);
    gemm_phase<EPI_PROJ>(p, p.abuf, D, p.WinT + (size_t)l * IN_PAD * D, Mfull, IN_PAD, D, ea, smem);
    grid_barrier(bar, xst);
#if PROBE == 1
    gemm_phase<EPI_PROJ>(p, p.abuf, D, p.WinT + (size_t)l * IN_PAD * D, Mfull, IN_PAD, D, ea, smem);
    grid_barrier(bar, xst);
#endif
#if PROBE == 3
    phaseC(p, l, smem, true);
    grid_barrier(bar, xst);
#endif
    phaseC(p, l, smem);
    grid_barrier(bar, xst);
#if PROBE == 2
    phaseD(p, l, smem, l + 2);
    grid_barrier(bar, xst);
#endif
    phaseD(p, l, smem, l);
    grid_barrier(bar, xst);
    readout_phase(p, l, Mout);
    grid_barrier(bar, xst);
    ea.hin_lat = hlat; ea.hin_ctx = hctx; ea.hout_lat = p.out; ea.hout_ctx = p.hctx; ea.gate = modl + 2 * 1024;
    gemm_phase<EPI_RES>(p, p.abuf, D, p.WoutT + (size_t)l * D * D, Mout, D, D, ea, smem);
    grid_barrier(bar, xst);
    prep_phase(p, p.out, p.hctx, p.norm2_g + l * D, modl, 3, 4, Mout);
    grid_barrier(bar, xst);
    gemm_phase<EPI_SWIGLU>(p, p.abuf, D, p.WguT + (size_t)l * 2 * FFN * D, Mout, 2 * FFN, D, ea, smem);
    grid_barrier(bar, xst);
#if PROBE == 1
    gemm_phase<EPI_SWIGLU>(p, p.abuf, D, p.WguT + (size_t)l * 2 * FFN * D, Mout, 2 * FFN, D, ea, smem);
    grid_barrier(bar, xst);
#endif
    ea.hin_lat = p.out; ea.hin_ctx = p.hctx; ea.gate = modl + 5 * 1024;
    gemm_phase<EPI_RES>(p, p.projA, FFN, p.WdT + (size_t)l * D * FFN, Mout, D, FFN, ea, smem);
    grid_barrier(bar, xst);
  }
  final_phase(p);
}

extern "C" void kernel_launch(void* const* d_in, const int* in_sizes, int n_in, void* d_out, int out_size, void* d_ws, size_t ws_size,
                              hipStream_t stream) {
  (void)in_sizes; (void)n_in; (void)out_size;
  Params p{};
  const float* const* in = reinterpret_cast<const float* const*>(d_in);
  p.x = in[0]; p.c = in[1]; p.ctx = in[2]; p.c_ctx = in[3]; p.norm1_g = in[4]; p.ada_w = in[5]; p.ada_b = in[6]; p.w_in = in[7];
  p.diff_lambda = in[8]; p.diff_norm_g = in[9]; p.q_norm_g = in[10]; p.k_norm_g = in[11]; p.gdn_conv_w = in[12]; p.gdn_a_log = in[13];
  p.gdn_dt_bias = in[14]; p.gdn_norm_g = in[15]; p.w_out = in[16]; p.norm2_g = in[17]; p.ffn_w_gu = in[18]; p.ffn_w_down = in[19];
  p.final_norm_g = in[20];
  p.out = (float*)d_out;
  char* w = (char*)d_ws;
  size_t off = 0;
  auto take = [&](size_t bytes) { char* r = w + off; off += (bytes + 255) & ~(size_t)255; return r; };
  p.WinT = (bf16*)take((size_t)2 * IN_PAD * D * 2);
  p.WoutT = (bf16*)take((size_t)2 * D * D * 2);
  p.WguT = (bf16*)take((size_t)2 * 2 * FFN * D * 2);
  p.WdT = (bf16*)take((size_t)2 * D * FFN * 2);
  p.mod = (float*)take((size_t)2 * 9 * 6144 * 4);
  p.tabD = (float*)take(64 * 8 * 2 * 4);
  p.tabG = (float*)take(64 * 16 * 2 * 4);
  p.cnt = (int*)take(256 + XB_WORDS * 4);
  p.hctx = (float*)take((size_t)NCTX * D * 4);
  p.abuf = (bf16*)take((size_t)NTOK * D * 2);
  p.projA = (bf16*)take((size_t)NTOK * PA * 2);
  p.projG = (bf16*)take((size_t)NTOK * PG * 2);
  p.projZ = (bf16*)take((size_t)NTOK * PZ * 2);
  p.ab = (float*)take((size_t)NTOK * 24 * 4);
  p.VtD = (bf16*)take((size_t)NB * 4 * 64 * NKEY * 2);
  p.VtG = (bf16*)take((size_t)NB * 2 * 64 * NKEY * 2);
  p.gq = (bf16*)take((size_t)NTOK * 384 * 2);
  p.gk = (bf16*)take((size_t)NTOK * 384 * 2);
  p.U = (bf16*)take((size_t)2 * NTOK * 384 * 2);
  p.W = (bf16*)take((size_t)2 * NTOK * 384 * 2);
  p.G = (float*)take((size_t)2 * NTOK * 6 * 4);
  p.stat = (float*)take((size_t)2 * 8704 * 2 * 4);
  p.Ob = p.projG;
  if (off > ws_size) { fprintf(stderr, "workspace too small: need %zu have %zu\n", off, ws_size); return; }
  static int grid_blocks = 0;
  if (!grid_blocks) {
    int dev = 0, cus = 0, per_cu = 0;
    hipGetDevice(&dev);
    hipDeviceGetAttribute(&cus, hipDeviceAttributeMultiprocessorCount, dev);
    hipOccupancyMaxActiveBlocksPerMultiprocessor(&per_cu, mega_kernel, NTHREADS, 0);
    if (per_cu > 2) per_cu = 2;
    if (per_cu < 1) per_cu = 1;
    grid_blocks = cus * per_cu;
  }
  hipMemsetAsync(p.cnt, 0, 256 + XB_WORDS * 4, stream);
  void* args[] = {&p};
  hipError_t e = hipLaunchCooperativeKernel((void*)mega_kernel, dim3(grid_blocks), dim3(NTHREADS), args, 0, stream);
  if (e != hipSuccess) fprintf(stderr, "cooperative launch failed: %s (grid %d)\n", hipGetErrorString(e), grid_blocks);
}
```

```cpp
#include <hip/hip_runtime.h>
#include <hip/hip_cooperative_groups.h>
#include <cstdio>
namespace cg = cooperative_groups;

#define DI __device__ __forceinline__
typedef unsigned short bf16;
typedef __attribute__((ext_vector_type(8))) short bf16x8;
typedef __attribute__((ext_vector_type(4))) short s16x4;
typedef __attribute__((ext_vector_type(16))) float f32x16;
typedef __attribute__((ext_vector_type(4))) unsigned u32x4;
typedef __attribute__((ext_vector_type(2))) unsigned u32x2;
typedef __bf16 bf16x2_t __attribute__((ext_vector_type(2)));
typedef float f32x2_t __attribute__((ext_vector_type(2)));

constexpr int D = 1024, NB = 8, SEQ = 4096, CTXL = 256;
constexpr int NLAT = NB * SEQ, NCTX = NB * CTXL, NTOK = NLAT + NCTX;
constexpr int IN_DIM = 2968, IN_PAD = 3072, FFN = 2816;
constexpr int PA = 1408, PG = 1152, PZ = 384;
constexpr int NKEY = CTXL + SEQ;
constexpr float LOG2E = 1.4426950408889634f;
constexpr int SMEM_BYTES = 65024;
constexpr int NTHREADS = 256;
#ifndef PROBE
#define PROBE 0
#endif

struct Params {
  const float *x, *c, *ctx, *c_ctx, *norm1_g, *ada_w, *ada_b, *w_in, *diff_lambda, *diff_norm_g, *q_norm_g, *k_norm_g,
      *gdn_conv_w, *gdn_a_log, *gdn_dt_bias, *gdn_norm_g, *w_out, *norm2_g, *ffn_w_gu, *ffn_w_down, *final_norm_g;
  float* out;
  bf16 *WinT, *WoutT, *WguT, *WdT;
  float *mod, *tabD, *tabG, *hctx;
  bf16 *abuf, *projA, *projG, *projZ;
  float* ab;
  bf16 *VtD, *VtG, *gq, *gk, *U, *W;
  float* G;
  bf16* Ob;
  int* cnt;
  float* stat;
  int never;
  int pad_;
};

DI unsigned pack2(float a, float b) {
  f32x2_t v = {a, b};
  bf16x2_t r = __builtin_convertvector(v, bf16x2_t);
  return __builtin_bit_cast(unsigned, r);
}
DI bf16 f2bf(float a) { return (bf16)(pack2(a, 0.f) & 0xffffu); }
DI float bf2f(bf16 u) { return __uint_as_float(((unsigned)u) << 16); }
DI float bflo(unsigned u) { return __uint_as_float(u << 16); }
DI float bfhi(unsigned u) { return __uint_as_float(u & 0xffff0000u); }
DI f32x16 mfma32(bf16x8 a, bf16x8 b, f32x16 c) { return __builtin_amdgcn_mfma_f32_32x32x16_bf16(a, b, c, 0, 0, 0); }
DI int crow(int reg, int h) { return (reg & 3) + 8 * (reg >> 2) + 4 * h; }
DI float silu_f(float v) { return v / (1.f + __expf(-v)); }
DI float ex2(float v) { return __builtin_amdgcn_exp2f(v); }
DI f32x16 zero16() { f32x16 z;
#pragma unroll
  for (int i = 0; i < 16; ++i) z[i] = 0.f; return z; }
DI bf16x8 pack_step(const f32x16& x, int s) {
  u32x4 p;
  p[0] = pack2(x[8 * s + 0], x[8 * s + 1]);
  p[1] = pack2(x[8 * s + 2], x[8 * s + 3]);
  p[2] = pack2(x[8 * s + 4], x[8 * s + 5]);
  p[3] = pack2(x[8 * s + 6], x[8 * s + 7]);
  return __builtin_bit_cast(bf16x8, p);
}
DI bf16x8 ldfrag_perm(const bf16* row, int k0) {
  u32x2 lo = *reinterpret_cast<const u32x2*>(row + k0);
  u32x2 hi = *reinterpret_cast<const u32x2*>(row + k0 + 8);
  u32x4 p = {lo[0], lo[1], hi[0], hi[1]};
  return __builtin_bit_cast(bf16x8, p);
}
DI bf16x8 ldfrag(const bf16* p) { return *reinterpret_cast<const bf16x8*>(p); }
DI int mod_row(int tok) { return tok < NLAT ? (tok >> 12) : 8; }
DI size_t a_off(int tok, int col, int K) { return ((((size_t)(tok >> 5) * (K >> 4) + (col >> 4))) << 9) + (((col >> 3) & 1) << 8) + ((tok & 31) << 3) + (col & 7); }
DI size_t b_off(int n, int k, int K) { return ((size_t)(n >> 7) * (K >> 5) + (k >> 5)) * 4096 + (n & 127) * 32 + (k & 31); }
DI int get_tid() { int t = threadIdx.x; asm volatile("" : "+v"(t)); return t; }
DI int get_bid() { int t = blockIdx.x; asm volatile("" : "+s"(t)); return t; }


#define XB_XCNT(j) (64 * (j))
#define XB_XSUB(j) (1024 + 64 * (j))
#define XB_XGEN(j) (2048 + 64 * (j))
#define XB_TOP 3072
#define XB_TOPGEN 3136
#define XB_WORDS 3200
DI unsigned xb_ld(unsigned* q) { return __hip_atomic_load(q, __ATOMIC_RELAXED, __HIP_MEMORY_SCOPE_AGENT); }
DI unsigned xb_add(unsigned* q, unsigned v) { return __hip_atomic_fetch_add(q, v, __ATOMIC_RELAXED, __HIP_MEMORY_SCOPE_AGENT); }
DI unsigned xb_xcc_id() { return (unsigned)__builtin_amdgcn_s_getreg((3 << 11) | 20) & 0xFu; }
#define XB_SPIN(cond) do { unsigned sp_ = 0; while (cond) { __builtin_amdgcn_s_sleep(1); if (++sp_ > (1u << 22)) break; } } while (0)

DI void grid_barrier(unsigned* bar, volatile unsigned* st) {
  asm volatile("s_waitcnt vmcnt(0) lgkmcnt(0)" ::: "memory");
  __syncthreads();
  if (get_tid() == 0) {
    const unsigned x = xb_xcc_id();
    unsigned nloc = st[0], nx = st[1];
    if (nloc == 0u) {
      const unsigned G = gridDim.x;
      unsigned sp = 0;
      for (;;) {
        unsigned sum = 0, cnt = 0, mine = 0;
        for (unsigned j = 0; j < 16; ++j) { const unsigned c = xb_ld(&bar[XB_XCNT(j)]); sum += c; cnt += (c > 0u) ? 1u : 0u; mine = (j == x) ? c : mine; }
        nloc = mine > 0u ? mine : 1u; nx = cnt > 0u ? cnt : 1u;
        if (sum == G) break;
        __builtin_amdgcn_s_sleep(1);
        if (++sp > (1u << 22)) break;
      }
      st[0] = nloc; st[1] = nx;
    }
    const unsigned old = xb_add(&bar[XB_XSUB(x)], 1u);
    const unsigned gen = old / nloc;
    if (old + 1u == (gen + 1u) * nloc) {
      __builtin_amdgcn_fence(__ATOMIC_RELEASE, "agent");
      asm volatile("s_waitcnt vmcnt(0)" ::: "memory");
      const unsigned og = xb_add(&bar[XB_TOP], 1u);
      const unsigned tg = og / nx;
      if (og + 1u == (tg + 1u) * nx) xb_add(&bar[XB_TOPGEN], 1u);
      else XB_SPIN(xb_ld(&bar[XB_TOPGEN]) == tg);
      __builtin_amdgcn_fence(__ATOMIC_ACQUIRE, "agent");
      xb_add(&bar[XB_XGEN(x)], 1u);
      asm volatile("s_waitcnt vmcnt(0)" ::: "memory");
    } else {
      XB_SPIN(xb_ld(&bar[XB_XGEN(x)]) == gen);
      __builtin_amdgcn_fence(__ATOMIC_ACQUIRE, "agent");
      asm volatile("s_waitcnt vmcnt(0)" ::: "memory");
    }
  }
  __syncthreads();
}

DI void sincos_d(double a, double& s, double& c) {
  double kq = rint(a * 0.63661977236758134308);
  double r = a - kq * 1.57079632679489661923;
  double r2 = r * r;
  double sp = r * (1.0 + r2 * (-1.0 / 6 + r2 * (1.0 / 120 + r2 * (-1.0 / 5040 + r2 * (1.0 / 362880 + r2 * (-1.0 / 39916800 + r2 * (1.0 / 6227020800.0)))))));
  double cp = 1.0 + r2 * (-0.5 + r2 * (1.0 / 24 + r2 * (-1.0 / 720 + r2 * (1.0 / 40320 + r2 * (-1.0 / 3628800 + r2 * (1.0 / 479001600.0 + r2 * (-1.0 / 87178291200.0)))))));
  int q = ((int)kq) & 3;
  if (q == 0) { s = sp; c = cp; }
  else if (q == 1) { s = cp; c = -sp; }
  else if (q == 2) { s = -sp; c = -cp; }
  else { s = -cp; c = sp; }
}

DI void ada_item(const Params& p, int it, char* smem) {
  const int tid = get_tid();
  const int l = it / 96, n0 = (it % 96) * 64;
  float* sc = (float*)smem;
  float* red = (float*)(smem + 36864);
  for (int i = tid; i < 9216; i += NTHREADS) {
    int r = i >> 10, k = i & 1023;
    float v = r < 8 ? p.c[r * 1024 + k] : p.c_ctx[k];
    sc[i] = silu_f(v);
  }
  __syncthreads();
  const int col = tid & 63, ks = tid >> 6;
  float acc[9];
#pragma unroll
  for (int r = 0; r < 9; ++r) acc[r] = 0.f;
  const float* wp = p.ada_w + ((size_t)l * 1024 + ks * 256) * 6144 + n0 + col;
  for (int k = 0; k < 256; k += 32) {
    float w[32];
#pragma unroll
    for (int u = 0; u < 32; ++u) w[u] = wp[(size_t)(k + u) * 6144];
#pragma unroll
    for (int u = 0; u < 32; ++u)
#pragma unroll
      for (int r = 0; r < 9; ++r) acc[r] += sc[r * 1024 + ks * 256 + k + u] * w[u];
  }
#pragma unroll
  for (int r = 0; r < 9; ++r) red[(ks * 9 + r) * 64 + col] = acc[r];
  __syncthreads();
  for (int i = tid; i < 576; i += NTHREADS) {
    int r = i >> 6, cc = i & 63;
    float s = red[(0 * 9 + r) * 64 + cc] + red[(1 * 9 + r) * 64 + cc] + red[(2 * 9 + r) * 64 + cc] + red[(3 * 9 + r) * 64 + cc];
    int n = n0 + cc;
    p.mod[(size_t)(l * 9 + r) * 6144 + n] = s + p.ada_b[l * 6144 + n];
  }
  __syncthreads();
}

DI void table_item(const Params& p) {
  const int tid = get_tid();
  for (int i = tid; i < 64 * 8; i += NTHREADS) {
    int pos = i >> 3, f = i & 7;
    float inv = ex2(-(float)f * (13.287712379549449f / 8.f));
    float ang = (float)pos * inv;
    double s, c; sincos_d((double)ang, s, c);
    p.tabD[2 * i] = (float)c; p.tabD[2 * i + 1] = (float)s;
  }
  for (int i = tid; i < 64 * 16; i += NTHREADS) {
    int pos = i >> 4, f = i & 15;
    float inv = ex2(-(float)f * (13.287712379549449f / 16.f));
    float ang = (float)pos * inv;
    double s, c; sincos_d((double)ang, s, c);
    p.tabG[2 * i] = (float)c; p.tabG[2 * i + 1] = (float)s;
  }
}

DI void wconv_tile(const float* src, int ld, bf16* dst, int K, int k0, int n0, int mode, char* smem) {
  const int tid = get_tid();
  float* tile = (float*)smem;
  {
    const int c = tid & 63, r0 = tid >> 6;
    const int n = n0 + c;
    int col;
    if (mode == 0) col = n < IN_DIM ? n : -1;
    else if (mode == 2) col = ((n >> 5) & 1) * FFN + (n >> 7) * 64 + ((n >> 6) & 1) * 32 + (n & 31);
    else col = n;
    float v[16];
#pragma unroll
    for (int i = 0; i < 16; ++i) v[i] = col >= 0 ? src[(size_t)(k0 + r0 * 16 + i) * ld + col] : 0.f;
#pragma unroll
    for (int i = 0; i < 16; ++i) tile[(r0 * 16 + i) * 65 + c] = v[i];
  }
  __syncthreads();
  {
    const int nn = tid >> 2, kseg = (tid & 3) * 16;
    unsigned w[8];
#pragma unroll
    for (int j = 0; j < 8; ++j) w[j] = pack2(tile[(kseg + 2 * j) * 65 + nn], tile[(kseg + 2 * j + 1) * 65 + nn]);
    u32x4* d = reinterpret_cast<u32x4*>(dst + b_off(n0 + nn, k0 + kseg, K));
    u32x4 a = {w[0], w[1], w[2], w[3]}, b = {w[4], w[5], w[6], w[7]};
    d[0] = a; d[1] = b;
  }
  __syncthreads();
}

DI void phase0(const Params& p, char* smem) {
  if (blockIdx.x == 0 && threadIdx.x < 16) p.cnt[threadIdx.x] = 0;
  constexpr int T_IN = 16 * 48, T_OUT = 16 * 16, T_GU = 16 * 88, T_DN = 44 * 16, T_L = T_IN + T_OUT + T_GU + T_DN;
  const int total = 193 + 2 * T_L;
  for (int it = blockIdx.x; it < total; it += gridDim.x) {
    if (it < 192) { ada_item(p, it, smem); continue; }
    if (it == 192) { table_item(p); continue; }
    int t = it - 193;
    int l = t / T_L; t -= l * T_L;
    if (t < T_IN) { int kt = t / 48, nt = t % 48;
      wconv_tile(p.w_in + (size_t)l * 1024 * IN_DIM, IN_DIM, p.WinT + (size_t)l * IN_PAD * 1024, 1024, kt * 64, nt * 64, 0, smem); continue; }
    t -= T_IN;
    if (t < T_OUT) { int kt = t / 16, nt = t % 16;
      wconv_tile(p.w_out + (size_t)l * 1024 * 1024, 1024, p.WoutT + (size_t)l * 1024 * 1024, 1024, kt * 64, nt * 64, 1, smem); continue; }
    t -= T_OUT;
    if (t < T_GU) { int kt = t / 88, nt = t % 88;
      wconv_tile(p.ffn_w_gu + (size_t)l * 1024 * 2 * FFN, 2 * FFN, p.WguT + (size_t)l * 2 * FFN * 1024, 1024, kt * 64, nt * 64, 2, smem); continue; }
    t -= T_GU;
    { int kt = t / 16, nt = t % 16;
      wconv_tile(p.ffn_w_down + (size_t)l * FFN * 1024, 1024, p.WdT + (size_t)l * 1024 * FFN, FFN, kt * 64, nt * 64, 1, smem); }
  }
}

DI void prep_phase(const Params& p, const float* hlat, const float* hctx, const float* g, const float* modl, int wsh, int wsc, int M) {
  const int tid = get_tid(), wave = tid >> 6, lane = tid & 63;
  for (int tok0 = get_bid() * 8 + wave * 2; tok0 < M; tok0 += gridDim.x * 8) {
    float4 v[2][4];
    float ss[2] = {0.f, 0.f};
#pragma unroll
    for (int rr = 0; rr < 2; ++rr) {
      const int tok = tok0 + rr;
      const float* row = tok < NLAT ? hlat + (size_t)tok * D : hctx + (size_t)(tok - NLAT) * D;
#pragma unroll
      for (int i = 0; i < 4; ++i) v[rr][i] = *reinterpret_cast<const float4*>(row + i * 256 + lane * 4);
    }
#pragma unroll
    for (int rr = 0; rr < 2; ++rr)
#pragma unroll
      for (int i = 0; i < 4; ++i) ss[rr] += v[rr][i].x * v[rr][i].x + v[rr][i].y * v[rr][i].y + v[rr][i].z * v[rr][i].z + v[rr][i].w * v[rr][i].w;
#pragma unroll
    for (int o = 32; o >= 1; o >>= 1) { ss[0] += __shfl_xor(ss[0], o); ss[1] += __shfl_xor(ss[1], o); }
#pragma unroll
    for (int rr = 0; rr < 2; ++rr) {
      const int tok = tok0 + rr;
      const float rstd = rsqrtf(ss[rr] * (1.f / D) + 1e-6f);
      const float* mr = modl + (size_t)mod_row(tok) * 6144;
#pragma unroll
      for (int i = 0; i < 4; ++i) {
        int col = i * 256 + lane * 4;
        float4 gg = *reinterpret_cast<const float4*>(g + col);
        float4 sh = *reinterpret_cast<const float4*>(mr + wsh * 1024 + col);
        float4 sc = *reinterpret_cast<const float4*>(mr + wsc * 1024 + col);
        float a0 = v[rr][i].x * rstd * gg.x * (1.f + sc.x) + sh.x;
        float a1 = v[rr][i].y * rstd * gg.y * (1.f + sc.y) + sh.y;
        float a2 = v[rr][i].z * rstd * gg.z * (1.f + sc.z) + sh.z;
        float a3 = v[rr][i].w * rstd * gg.w * (1.f + sc.w) + sh.w;
        u32x2 o = {pack2(a0, a1), pack2(a2, a3)};
        *reinterpret_cast<u32x2*>(p.abuf + a_off(tok, col, D)) = o;
      }
    }
  }
}

enum { EPI_PROJ = 0, EPI_RES = 1, EPI_SWIGLU = 2 };
struct EpiArgs {
  const float* hin_lat; const float* hin_ctx; float* hout_lat; float* hout_ctx; const float* gate;
};

template <int EPI>
DI void gemm_tile(const Params& p, const bf16* A, int lda, const bf16* Bt, int K, int mt, int nt, int mtn, int ntn2, bool first, bool has_next,
                  bf16x8 (&af)[2][2][2], u32x4 (&rb)[2][2], const EpiArgs& ea, char* smem) {
  constexpr int LS = 40, STG = 128 * LS;
  bf16* Sm = (bf16*)smem;
  const int tid = get_tid(), wave = tid >> 6, lane = tid & 63, l31 = lane & 31, hh = lane >> 5;
  const int m0 = mt * 256, n0 = nt * 128;
  f32x16 acc[2][4];
#pragma unroll
  for (int i = 0; i < 2; ++i)
#pragma unroll
    for (int j = 0; j < 4; ++j) acc[i][j] = zero16();
  const int nk = K / 32, kb16 = K >> 4;
  const bf16* Ag = A + (((size_t)(mt * 8 + wave * 2) * kb16) << 9) + hh * 256 + l31 * 8;
  const int lrow = tid >> 2, lcc = tid & 3;
  const bf16* Bg = Bt + (size_t)nt * (K >> 5) * 4096 + lrow * 32 + lcc * 8;
  auto gloadA = [&](bf16x8 (*f)[2], int kt) {
    const int k2 = min(kt, nk - 1) * 2;
#pragma unroll
    for (int s2 = 0; s2 < 2; ++s2)
#pragma unroll
      for (int i = 0; i < 2; ++i) f[s2][i] = *reinterpret_cast<const bf16x8*>(Ag + (((size_t)i * kb16 + k2 + s2) << 9));
  };
  auto gloadB = [&](u32x4* r, int kt) {
    const int k = min(kt, nk - 1);
#pragma unroll
    for (int i = 0; i < 2; ++i) r[i] = *reinterpret_cast<const u32x4*>(Bg + (size_t)k * 4096 + i * 2048);
  };
  auto lstoreB = [&](const u32x4* r, int buf) {
    bf16* d = Sm + buf * STG + lrow * LS + lcc * 8;
#pragma unroll
    for (int i = 0; i < 2; ++i) *reinterpret_cast<u32x4*>(d + i * 64 * LS) = r[i];
  };
  auto compute = [&](bf16x8 (*f)[2], int buf) {
    const bf16* Bb = Sm + buf * STG + l31 * LS + hh * 8;
    bf16x8 bfr[2][4];
#pragma unroll
    for (int s2 = 0; s2 < 2; ++s2)
#pragma unroll
      for (int j = 0; j < 4; ++j) bfr[s2][j] = ldfrag(Bb + j * 32 * LS + s2 * 16);
#pragma unroll
    for (int s2 = 0; s2 < 2; ++s2)
#pragma unroll
      for (int i = 0; i < 2; ++i)
#pragma unroll
        for (int j = 0; j < 4; ++j) acc[i][j] = mfma32(f[s2][i], bfr[s2][j], acc[i][j]);
  };
  if (first) {
    gloadA(af[0], 0);
    gloadA(af[1], 1);
    gloadB(rb[0], 0);
    gloadB(rb[1], 1);
  }
  lstoreB(rb[0], 0);
  __syncthreads();
  for (int kt = 0; kt < nk; kt += 2) {
    gloadB(rb[0], kt + 2);
    __builtin_amdgcn_sched_barrier(0);
    compute(af[0], 0);
    gloadA(af[0], kt + 2);
    lstoreB(rb[1], 1);
    __syncthreads();
    gloadB(rb[1], kt + 3);
    __builtin_amdgcn_sched_barrier(0);
    compute(af[1], 1);
    gloadA(af[1], kt + 3);
    lstoreB(rb[0], 0);
    __syncthreads();
  }
  if (has_next) {
    const bf16* Agn = A + (((size_t)(mtn * 8 + wave * 2) * kb16) << 9) + hh * 256 + l31 * 8;
    const bf16* Bgn = Bt + (size_t)ntn2 * (K >> 5) * 4096 + lrow * 32 + lcc * 8;
#pragma unroll
    for (int st = 0; st < 2; ++st) {
#pragma unroll
      for (int s2 = 0; s2 < 2; ++s2)
#pragma unroll
        for (int i = 0; i < 2; ++i) af[st][s2][i] = *reinterpret_cast<const bf16x8*>(Agn + (((size_t)i * kb16 + 2 * st + s2) << 9));
#pragma unroll
      for (int i = 0; i < 2; ++i) rb[st][i] = *reinterpret_cast<const u32x4*>(Bgn + (size_t)st * 4096 + i * 2048);
    }
  }
  {
    char* slab = smem + wave * 9216;
    if (EPI == EPI_PROJ && nt == 23) {
#pragma unroll
      for (int i = 0; i < 2; ++i)
#pragma unroll
        for (int r = 0; r < 16; ++r) {
          const int tok = m0 + wave * 64 + i * 32 + crow(r, hh);
          if (l31 < 24) p.ab[(size_t)tok * 24 + l31] = acc[i][0][r];
        }
    } else if (EPI == EPI_PROJ || EPI == EPI_SWIGLU) {
      bf16* stg = (bf16*)slab;
#pragma unroll
      for (int jh = 0; jh < 2; ++jh) {
#pragma unroll
        for (int ii = 0; ii < 2; ++ii)
#pragma unroll
          for (int r = 0; r < 16; ++r) {
            const int row = ii * 32 + crow(r, hh);
            if (EPI == EPI_PROJ) {
              stg[row * 72 + l31] = f2bf(acc[ii][2 * jh][r]);
              stg[row * 72 + 32 + l31] = f2bf(acc[ii][2 * jh + 1][r]);
            } else {
              stg[row * 72 + l31] = f2bf(silu_f(acc[ii][2 * jh][r]) * acc[ii][2 * jh + 1][r]);
            }
          }
        asm volatile("s_waitcnt lgkmcnt(0)" ::: "memory");
        if (EPI == EPI_PROJ) {
#pragma unroll
          for (int q = 0; q < 8; ++q) {
            const int idx = q * 64 + lane, row = idx >> 3, seg = idx & 7;
            const u32x4 v = *reinterpret_cast<const u32x4*>(stg + row * 72 + seg * 8);
            const int tok = m0 + wave * 64 + row;
            const int cidx = n0 + jh * 64 + seg * 8;
            bf16* dst;
            if (nt < 11) dst = p.projA + (size_t)tok * PA + cidx;
            else if (nt < 20) dst = p.projG + (size_t)tok * PG + (cidx - PA);
            else dst = p.projZ + (size_t)tok * PZ + (cidx - PA - PG);
            *reinterpret_cast<u32x4*>(dst) = v;
          }
        } else {
#pragma unroll
          for (int q = 0; q < 4; ++q) {
            const int idx = q * 64 + lane, row = idx >> 2, seg = idx & 3;
            const u32x4 v = *reinterpret_cast<const u32x4*>(stg + row * 72 + seg * 8);
            const int tok = m0 + wave * 64 + row;
            *reinterpret_cast<u32x4*>(p.projA + a_off(tok, nt * 64 + jh * 32 + seg * 8, FFN)) = v;
          }
        }
        asm volatile("s_waitcnt lgkmcnt(0)" ::: "memory");
      }
    } else {
      float* stg = (float*)slab;
#pragma unroll
      for (int i = 0; i < 2; ++i)
#pragma unroll
        for (int jh = 0; jh < 2; ++jh) {
#pragma unroll
          for (int r = 0; r < 16; ++r) {
            stg[crow(r, hh) * 68 + l31] = acc[i][2 * jh][r];
            stg[crow(r, hh) * 68 + 32 + l31] = acc[i][2 * jh + 1][r];
          }
          asm volatile("s_waitcnt lgkmcnt(0)" ::: "memory");
#pragma unroll
          for (int q = 0; q < 8; ++q) {
            const int idx = q * 64 + lane, row = idx >> 4, seg = idx & 15;
            const float4 a = *reinterpret_cast<const float4*>(stg + row * 68 + seg * 4);
            const int tok = m0 + wave * 64 + i * 32 + row;
            const int cidx = n0 + jh * 64 + seg * 4;
            const float* hin = tok < NLAT ? ea.hin_lat + (size_t)tok * D : ea.hin_ctx + (size_t)(tok - NLAT) * D;
            float* hout = tok < NLAT ? ea.hout_lat + (size_t)tok * D : ea.hout_ctx + (size_t)(tok - NLAT) * D;
            const float4 hv = *reinterpret_cast<const float4*>(hin + cidx);
            const float4 gt = *reinterpret_cast<const float4*>(ea.gate + (size_t)mod_row(tok) * 6144 + cidx);
            float4 o = {hv.x + gt.x * a.x, hv.y + gt.y * a.y, hv.z + gt.z * a.z, hv.w + gt.w * a.w};
            *reinterpret_cast<float4*>(hout + cidx) = o;
          }
          asm volatile("s_waitcnt lgkmcnt(0)" ::: "memory");
        }
    }
    __syncthreads();
  }
}

template <int EPI>
DI void gemm_phase(const Params& p, const bf16* A, int lda, const bf16* Bt, int M, int N, int K, const EpiArgs& ea, char* smem) {
  const int ntm = M / 256, ntn = N / 128;
  const int bid = get_bid();
  const int x = bid & 7, j = bid >> 3, nloc = gridDim.x >> 3;
  const int R = ntm >> 3;
  auto decode = [&](int u, int& mt, int& nt) {
    const int rg = u / (8 * ntn), rem = u - rg * 8 * ntn;
    const int gs = min(8, R - rg * 8);
    nt = rem / gs;
    mt = x * R + rg * 8 + (rem - nt * gs);
  };
  bf16x8 af[2][2][2];
  u32x4 rb[2][2];
  bool first = true;
  for (int u = j; u < R * ntn; u += nloc) {
    int mt, nt, mtn = 0, ntn2 = 0;
    decode(u, mt, nt);
    const bool has_next = u + nloc < R * ntn;
    if (has_next) decode(u + nloc, mtn, ntn2);
    gemm_tile<EPI>(p, A, lda, Bt, K, mt, nt, mtn, ntn2, first, has_next, af, rb, ea, smem);
    first = false;
  }
}

DI void tokblock_info(int tb, int& tok0, int& seq_tok0, int& t0, int& seqlen, int& b, int& isctx) {
  if (tb < 512) { b = tb >> 6; t0 = (tb & 63) * 64; seq_tok0 = b * SEQ; seqlen = SEQ; isctx = 0; }
  else { int u = tb - 512; b = u >> 2; t0 = (u & 3) * 64; seq_tok0 = NLAT + b * CTXL; seqlen = CTXL; isctx = 1; }
  tok0 = seq_tok0 + t0;
}

DI void headvec_unit(const Params& p, int l, int u, int item) {
  const int tok = u >> 4, hu = u & 15;
  int col0;
  if (hu < 4) col0 = hu * 64; else if (hu < 8) col0 = 256 + (hu - 4) * 64; else if (hu < 14) col0 = 768 + (hu - 8) * 64; else col0 = 1152 + (hu - 14) * 64;
  bf16* ptr = p.projA + (size_t)tok * PA + col0;
  float x[64];
#pragma unroll
  for (int i = 0; i < 8; ++i) {
    u32x4 v = reinterpret_cast<const u32x4*>(ptr)[i];
#pragma unroll
    for (int j = 0; j < 4; ++j) { x[i * 8 + 2 * j] = bflo(v[j]); x[i * 8 + 2 * j + 1] = bfhi(v[j]); }
  }
  const bool lat = tok < NLAT;
  const int t = tok & (SEQ - 1);
  const int prow = t >> 6, pcol = t & 63;
  float scale = 1.f;
  if (hu < 8) {
    if (lat) {
#pragma unroll
      for (int comp = 0; comp < 2; ++comp)
#pragma unroll
        for (int ax = 0; ax < 2; ++ax) {
          const float* tb = p.tabD + (ax == 0 ? prow : pcol) * 16;
#pragma unroll
          for (int f = 0; f < 8; ++f) {
            float c = tb[2 * f], s = tb[2 * f + 1];
            float x1 = x[comp * 32 + ax * 16 + f], x2 = x[comp * 32 + ax * 16 + 8 + f];
            x[comp * 32 + ax * 16 + f] = x1 * c - x2 * s;
            x[comp * 32 + ax * 16 + 8 + f] = x2 * c + x1 * s;
          }
        }
    }
    if (hu < 4) scale = 0.17677669529663687f * LOG2E;
  } else {
    float ss = 0.f;
#pragma unroll
    for (int i = 0; i < 64; ++i) ss += x[i] * x[i];
    const float r = rsqrtf(ss * (1.f / 64.f) + 1e-6f);
    const float* g = (hu < 14 ? p.q_norm_g : p.k_norm_g) + l * 64;
#pragma unroll
    for (int i = 0; i < 64; ++i) x[i] = x[i] * r * g[i];
    if (lat) {
#pragma unroll
      for (int ax = 0; ax < 2; ++ax) {
        const float* tb = p.tabG + (ax == 0 ? prow : pcol) * 32;
#pragma unroll
        for (int f = 0; f < 16; ++f) {
          float c = tb[2 * f], s = tb[2 * f + 1];
          float x1 = x[ax * 32 + f], x2 = x[ax * 32 + 16 + f];
          x[ax * 32 + f] = x1 * c - x2 * s;
          x[ax * 32 + 16 + f] = x2 * c + x1 * s;
        }
      }
    }
    if (hu < 14) scale = 0.125f * LOG2E;
  }
  float nrm2 = 0.f;
#pragma unroll
  for (int i = 0; i < 8; ++i) {
    u32x4 v;
#pragma unroll
    for (int j = 0; j < 4; ++j) {
      const float a0 = x[i * 8 + 2 * j] * scale, a1 = x[i * 8 + 2 * j + 1] * scale;
      nrm2 += a0 * a0 + a1 * a1;
      v[j] = pack2(a0, a1);
    }
    reinterpret_cast<u32x4*>(ptr)[i] = v;
  }
  float mq = hu < 4 ? nrm2 : 0.f, mk = (hu >= 4 && hu < 8) ? nrm2 : 0.f;
#pragma unroll
  for (int o = 32; o >= 1; o >>= 1) { mq = fmaxf(mq, __shfl_xor(mq, o)); mk = fmaxf(mk, __shfl_xor(mk, o)); }
  const int tid = get_tid();
  if ((tid & 63) == 0) {
    float* st = p.stat + ((size_t)l * 8704 + item * 4 + (tid >> 6)) * 2;
    st[0] = mq; st[1] = mk;
  }
}

DI void vtrans_item(const Params& p, int it, char* smem) {
  const int tid = get_tid();
  const int tb = it / 6, vh = it % 6;
  int tok0, seq_tok0, t0, seqlen, b, isctx;
  tokblock_info(tb, tok0, seq_tok0, t0, seqlen, b, isctx);
  bf16* tile = (bf16*)smem;
  const int col0 = vh < 4 ? 512 + vh * 64 : 1280 + (vh - 4) * 64;
  {
    const int row = tid >> 2, seg = tid & 3;
    const u32x4* src = reinterpret_cast<const u32x4*>(p.projA + (size_t)(tok0 + row) * PA + col0 + seg * 16);
    u32x4 a = src[0], c = src[1];
    unsigned* d = reinterpret_cast<unsigned*>(tile + row * 66 + seg * 16);
    d[0] = a[0]; d[1] = a[1]; d[2] = a[2]; d[3] = a[3]; d[4] = c[0]; d[5] = c[1]; d[6] = c[2]; d[7] = c[3];
  }
  __syncthreads();
  {
    const int dv = tid >> 2, kseg = (tid & 3) * 16;
    unsigned w[8];
#pragma unroll
    for (int j = 0; j < 8; ++j) w[j] = (unsigned)tile[(kseg + 2 * j) * 66 + dv] | ((unsigned)tile[(kseg + 2 * j + 1) * 66 + dv] << 16);
    bf16* dstbase = vh < 4 ? p.VtD + ((size_t)(b * 4 + vh) * 64 + dv) * NKEY : p.VtG + ((size_t)(b * 2 + vh - 4) * 64 + dv) * NKEY;
    const int key0 = (isctx ? 0 : CTXL) + t0 + kseg;
    u32x4 a = {w[0], w[1], w[2], w[3]}, c = {w[4], w[5], w[6], w[7]};
    reinterpret_cast<u32x4*>(dstbase + key0)[0] = a;
    reinterpret_cast<u32x4*>(dstbase + key0)[1] = c;
  }
  __syncthreads();
}

template <int S>
DI void gdn_diag_block2(f32x16& R0, f32x16& R1, const bf16* nL0, const bf16* nL1, int rowbase, int hh) {
#pragma unroll
  for (int rho = 0; rho < 16; ++rho) {
    const int ho = (rho >> 2) & 1, qo = (rho & 3) + 4 * (rho >> 3);
    const float own0 = R0[8 * S + qo], own1 = R1[8 * S + qo];
    const float oth0 = __shfl_xor(own0, 32), oth1 = __shfl_xor(own1, 32);
    const float x0 = (hh == ho) ? own0 : oth0, x1 = (hh == ho) ? own1 : oth1;
#pragma unroll
    for (int q = 0; q < 8; ++q) {
      const int rmax = (q & 3) + 8 * (q >> 2) + 4;
      if (rmax > rho) {
        const int rp = (q & 3) + 8 * (q >> 2) + 4 * hh;
        const int o = (rowbase + rp) * 72 + rowbase + rho;
        R0[8 * S + q] += bf2f(nL0[o]) * x0;
        R1[8 * S + q] += bf2f(nL1[o]) * x1;
      }
    }
  }
}

DI void gdn_local_item(const Params& p, int l, int it, char* smem) {
  const int tid = get_tid(), wave = tid >> 6, lane = tid & 63, l31 = lane & 31, hh = lane >> 5;
  const int tb = it / 6, h = it % 6;
  int tok0, seq_tok0, t0, seqlen, b, isctx;
  tokblock_info(tb, tok0, seq_tok0, t0, seqlen, b, isctx);
  float* tmp = (float*)smem;
  float* vf = tmp + 64 * 65;
  bf16* kb = (bf16*)(vf + 64 * 65);
  bf16* nL = kb + 64 * 72;
  float* gsm = (float*)(nL + 2 * 64 * 72);
  float* bs = gsm; float* Gs = gsm + 128; float* rn = gsm + 256;
  const int cp = tid & 31, seg = tid >> 5;
  unsigned xin[3][12];
#pragma unroll
  for (int m = 0; m < 3; ++m)
#pragma unroll
    for (int r = 0; r < 12; ++r) {
      const int sidx = t0 + seg * 8 + r - 2;
      unsigned v = 0;
      if (sidx >= 0 && sidx < seqlen) v = *reinterpret_cast<const unsigned*>(p.projG + (size_t)(seq_tok0 + sidx) * PG + m * 384 + h * 64 + 2 * cp);
      xin[m][r] = v;
    }
  if (tid < 128) {
    const int dir = tid >> 6, i = lane;
    const float* abp = p.ab + (size_t)(tok0 + i) * 24;
    const float a = abp[dir * 6 + h], bb = abp[12 + dir * 6 + h];
    const float z = a + p.gdn_dt_bias[l * 12 + dir * 6 + h];
    const float e = __expf(-fabsf(z));
    const float l1p = e < 1e-2f ? e * (1.f - e * (0.5f - e * (1.f / 3.f))) : __logf(1.f + e);
    const float sp = fmaxf(z, 0.f) + l1p;
    const float g = -__expf(p.gdn_a_log[l * 12 + dir * 6 + h]) * sp;
    const float beta = 1.f / (1.f + __expf(-bb));
    float cs = g;
    if (dir == 0) {
#pragma unroll
      for (int o = 1; o < 64; o <<= 1) { float t = __shfl_up(cs, o); if (i >= o) cs += t; }
    } else {
#pragma unroll
      for (int o = 1; o < 64; o <<= 1) { float t = __shfl_down(cs, o); if (i + o < 64) cs += t; }
    }
    bs[dir * 64 + i] = beta; Gs[dir * 64 + i] = cs;
    p.G[((size_t)dir * NTOK + tok0 + i) * 6 + h] = cs;
  }
#pragma unroll
  for (int m = 0; m < 3; ++m) {
    float* dst = m == 2 ? vf : tmp;
    const float* cw = p.gdn_conv_w + (size_t)l * 5 * PG + m * 384 + h * 64 + 2 * cp;
    float w0[5], w1[5];
#pragma unroll
    for (int j = 0; j < 5; ++j) { w0[j] = cw[j * PG]; w1[j] = cw[j * PG + 1]; }
#pragma unroll
    for (int r = 0; r < 8; ++r) {
      float a0 = 0.f, a1 = 0.f;
#pragma unroll
      for (int j = 0; j < 5; ++j) { a0 += w0[j] * bflo(xin[m][r + j]); a1 += w1[j] * bfhi(xin[m][r + j]); }
      dst[(seg * 8 + r) * 65 + 2 * cp] = silu_f(a0);
      dst[(seg * 8 + r) * 65 + 2 * cp + 1] = silu_f(a1);
    }
    __syncthreads();
    if (m < 2) {
      {
        const int row = tid >> 2, qt = tid & 3;
        float ss = 0.f;
#pragma unroll
        for (int c = 0; c < 16; ++c) { float v = tmp[row * 65 + qt * 16 + c]; ss += v * v; }
        ss += __shfl_xor(ss, 1); ss += __shfl_xor(ss, 2);
        if (qt == 0) rn[row] = rsqrtf(ss + 1e-6f) * (m == 0 ? 0.125f : 1.f);
      }
      __syncthreads();
      bf16* gdst = (m == 0 ? p.gq : p.gk) + (size_t)tok0 * 384 + h * 64;
      for (int idx = tid; idx < 2048; idx += NTHREADS) {
        const int tau = idx >> 5, c = (idx & 31) * 2;
        const float r = rn[tau];
        unsigned w = pack2(tmp[tau * 65 + c] * r, tmp[tau * 65 + c + 1] * r);
        *reinterpret_cast<unsigned*>(gdst + (size_t)tau * 384 + c) = w;
        if (m == 1) *reinterpret_cast<unsigned*>(kb + tau * 72 + c) = w;
      }
      __syncthreads();
    }
  }
  {
    const int wi = wave >> 1, wj = wave & 1;
    f32x16 kk = zero16();
#pragma unroll
    for (int s = 0; s < 4; ++s) {
      bf16x8 a = ldfrag(kb + (32 * wi + l31) * 72 + 16 * s + 8 * hh);
      bf16x8 bq = ldfrag(kb + (32 * wj + l31) * 72 + 16 * s + 8 * hh);
      kk = mfma32(a, bq, kk);
    }
    const int j = 32 * wj + l31;
    const float G0j = Gs[j], G1j = Gs[64 + j];
#pragma unroll
    for (int r = 0; r < 16; ++r) {
      const int i = 32 * wi + crow(r, hh);
      const float v0 = kk[r] * __expf(Gs[i] - G0j) * bs[i];
      const float v1 = kk[r] * __expf(Gs[64 + i] - G1j) * bs[64 + i];
      nL[i * 72 + j] = f2bf(i > j ? -v0 : 0.f);
      nL[64 * 72 + (63 - i) * 72 + (63 - j)] = f2bf(i < j ? -v1 : 0.f);
    }
  }
  __syncthreads();
  {
    const bf16* nL0 = nL; const bf16* nL1 = nL + 64 * 72;
    f32x16 R0[2], R1[2];
#pragma unroll
    for (int t = 0; t < 2; ++t)
#pragma unroll
      for (int r = 0; r < 16; ++r) {
        const int fi = 32 * t + crow(r, hh);
        const int i1 = 63 - fi;
        float v0, v1;
        if (wave < 2) { v0 = vf[fi * 65 + 32 * wave + l31] * bs[fi]; v1 = vf[i1 * 65 + 32 * wave + l31] * bs[64 + i1]; }
        else {
          v0 = bf2f(kb[fi * 72 + 32 * (wave - 2) + l31]) * bs[fi] * __expf(Gs[fi]);
          v1 = bf2f(kb[i1 * 72 + 32 * (wave - 2) + l31]) * bs[64 + i1] * __expf(Gs[64 + i1]);
        }
        R0[t][r] = v0; R1[t][r] = v1;
      }
    const bf16x8 z8 = {0, 0, 0, 0, 0, 0, 0, 0};
    gdn_diag_block2<0>(R0[0], R1[0], nL0, nL1, 0, hh);
    {
      bf16x8 xb0 = pack_step(R0[0], 0), xb1 = pack_step(R1[0], 0);
      bf16x8 a00 = ldfrag_perm(nL0 + l31 * 72, 4 * hh), a10 = ldfrag_perm(nL1 + l31 * 72, 4 * hh);
      if (l31 < 16) { a00 = z8; a10 = z8; }
      R0[0] = mfma32(a00, xb0, R0[0]); R1[0] = mfma32(a10, xb1, R1[0]);
      R0[1] = mfma32(ldfrag_perm(nL0 + (32 + l31) * 72, 4 * hh), xb0, R0[1]);
      R1[1] = mfma32(ldfrag_perm(nL1 + (32 + l31) * 72, 4 * hh), xb1, R1[1]);
    }
    gdn_diag_block2<1>(R0[0], R1[0], nL0, nL1, 16, hh);
    {
      bf16x8 xb0 = pack_step(R0[0], 1), xb1 = pack_step(R1[0], 1);
      R0[1] = mfma32(ldfrag_perm(nL0 + (32 + l31) * 72, 16 + 4 * hh), xb0, R0[1]);
      R1[1] = mfma32(ldfrag_perm(nL1 + (32 + l31) * 72, 16 + 4 * hh), xb1, R1[1]);
    }
    gdn_diag_block2<0>(R0[1], R1[1], nL0, nL1, 32, hh);
    {
      bf16x8 xb0 = pack_step(R0[1], 0), xb1 = pack_step(R1[1], 0);
      bf16x8 a01 = ldfrag_perm(nL0 + (32 + l31) * 72, 32 + 4 * hh), a11 = ldfrag_perm(nL1 + (32 + l31) * 72, 32 + 4 * hh);
      if (l31 < 16) { a01 = z8; a11 = z8; }
      R0[1] = mfma32(a01, xb0, R0[1]); R1[1] = mfma32(a11, xb1, R1[1]);
    }
    gdn_diag_block2<1>(R0[1], R1[1], nL0, nL1, 48, hh);
    {
      const size_t cbase = (size_t)h * 64 + 32 * (wave & 1) + l31;
      bf16* ob0 = (wave < 2 ? p.U : p.W) + (size_t)tok0 * 384 + cbase;
      bf16* ob1 = (wave < 2 ? p.U : p.W) + ((size_t)NTOK + tok0) * 384 + cbase;
#pragma unroll
      for (int t = 0; t < 2; ++t)
#pragma unroll
        for (int r = 0; r < 16; ++r) {
          const int fi = 32 * t + crow(r, hh);
          ob0[(size_t)fi * 384] = f2bf(R0[t][r]);
          ob1[(size_t)(63 - fi) * 384] = f2bf(R1[t][r]);
        }
    }
  }
  __syncthreads();
}

DI void gdn_scan_item(const Params& p, int it, char* smem) {
  const int tid = get_tid(), wave = tid >> 6, lane = tid & 63, l31 = lane & 31, hh = lane >> 5;
  const int b = it / 12, h = (it % 12) >> 1, dir = it & 1;
  constexpr int LS = 72;
  bf16* Qr = (bf16*)smem; bf16* Kr = Qr + 64 * LS; bf16* nW = Kr + 64 * LS; bf16* Qd = nW + 64 * LS;
  bf16* QK = Qd + 64 * LS; bf16* KdT = QK + 64 * LS; bf16* Ub = KdT + 64 * LS;
  float* Gs = (float*)(Ub + 64 * LS);
  f32x16 S[2];
  S[0] = zero16(); S[1] = zero16();
  const bf16* Ud = p.U + (size_t)dir * NTOK * 384;
  const bf16* Wd = p.W + (size_t)dir * NTOK * 384;
  const float* Gd = p.G + (size_t)dir * NTOK * 6;
  bf16* Od = p.Ob + (size_t)dir * NTOK * 384;
  for (int ci = 0; ci < 68; ++ci) {
    int tok0;
    if (ci < 4) tok0 = NLAT + b * CTXL + (dir ? 3 - ci : ci) * 64;
    else tok0 = b * SEQ + (dir ? 67 - ci : ci - 4) * 64;
    const float gtot = Gd[(size_t)(tok0 + (dir ? 0 : 63)) * 6 + h];
#pragma unroll
    for (int ii = 0; ii < 2; ++ii) {
      const int cidx = tid + ii * 256, row = cidx >> 3, cc = cidx & 7;
      const size_t off = (size_t)(tok0 + row) * 384 + h * 64 + cc * 8;
      const u32x4 q = *reinterpret_cast<const u32x4*>(p.gq + off);
      const u32x4 k = *reinterpret_cast<const u32x4*>(p.gk + off);
      const u32x4 w = *reinterpret_cast<const u32x4*>(Wd + off);
      const u32x4 u = *reinterpret_cast<const u32x4*>(Ud + off);
      const float Gi = Gd[(size_t)(tok0 + row) * 6 + h];
      const float eq = __expf(Gi), ek = __expf(gtot - Gi);
      const int lo = row * LS + cc * 8;
      *reinterpret_cast<u32x4*>(Qr + lo) = q;
      *reinterpret_cast<u32x4*>(Kr + lo) = k;
      *reinterpret_cast<u32x4*>(Ub + lo) = u;
      u32x4 nw, qd;
#pragma unroll
      for (int j = 0; j < 4; ++j) {
        nw[j] = w[j] ^ 0x80008000u;
        qd[j] = pack2(bflo(q[j]) * eq, bfhi(q[j]) * eq);
        KdT[(cc * 8 + 2 * j) * LS + row] = f2bf(bflo(k[j]) * ek);
        KdT[(cc * 8 + 2 * j + 1) * LS + row] = f2bf(bfhi(k[j]) * ek);
      }
      *reinterpret_cast<u32x4*>(nW + lo) = nw;
      *reinterpret_cast<u32x4*>(Qd + lo) = qd;
      if (cc == 0) Gs[row] = Gi;
    }
    __syncthreads();
    {
      const int wi = wave >> 1, wj = wave & 1;
      f32x16 acc = zero16();
#pragma unroll
      for (int s = 0; s < 4; ++s) {
        bf16x8 a = ldfrag(Qr + (32 * wi + l31) * LS + 16 * s + 8 * hh);
        bf16x8 bq = ldfrag(Kr + (32 * wj + l31) * LS + 16 * s + 8 * hh);
        acc = mfma32(a, bq, acc);
      }
      const int j = 32 * wj + l31;
      const float Gj = Gs[j];
#pragma unroll
      for (int r = 0; r < 16; ++r) {
        const int i = 32 * wi + crow(r, hh);
        const bool ok = dir ? (i <= j) : (i >= j);
        const float v = acc[r] * __expf(Gs[i] - Gj);
        QK[i * LS + j] = f2bf(ok ? v : 0.f);
      }
    }
    __syncthreads();
    if (wave < 2) {
      const int c = wave;
      const float glast = __expf(gtot);
      bf16x8 Sf[2][2];
#pragma unroll
      for (int a = 0; a < 2; ++a)
#pragma unroll
        for (int s = 0; s < 2; ++s) Sf[a][s] = pack_step(S[a], s);
      f32x16 vn[2], o[2];
#pragma unroll
      for (int r = 0; r < 2; ++r) {
#pragma unroll
        for (int reg = 0; reg < 16; ++reg) vn[r][reg] = bf2f(Ub[(32 * r + crow(reg, hh)) * LS + 32 * c + l31]);
        o[r] = zero16();
#pragma unroll
        for (int a = 0; a < 2; ++a)
#pragma unroll
          for (int s = 0; s < 2; ++s) {
            const int k0 = 32 * a + 16 * s + 4 * hh;
            vn[r] = mfma32(ldfrag_perm(nW + (32 * r + l31) * LS, k0), Sf[a][s], vn[r]);
            o[r] = mfma32(ldfrag_perm(Qd + (32 * r + l31) * LS, k0), Sf[a][s], o[r]);
          }
      }
      bf16x8 Vf[2][2];
#pragma unroll
      for (int r = 0; r < 2; ++r)
#pragma unroll
        for (int s = 0; s < 2; ++s) Vf[r][s] = pack_step(vn[r], s);
#pragma unroll
      for (int a = 0; a < 2; ++a) {
#pragma unroll
        for (int reg = 0; reg < 16; ++reg) S[a][reg] *= glast;
      }
#pragma unroll
      for (int r2 = 0; r2 < 2; ++r2)
#pragma unroll
        for (int s = 0; s < 2; ++s) {
          const int k0 = 32 * r2 + 16 * s + 4 * hh;
#pragma unroll
          for (int r = 0; r < 2; ++r) o[r] = mfma32(ldfrag_perm(QK + (32 * r + l31) * LS, k0), Vf[r2][s], o[r]);
#pragma unroll
          for (int a = 0; a < 2; ++a) S[a] = mfma32(ldfrag_perm(KdT + (32 * a + l31) * LS, k0), Vf[r2][s], S[a]);
        }
#pragma unroll
      for (int r = 0; r < 2; ++r)
#pragma unroll
        for (int reg = 0; reg < 16; ++reg)
          Od[(size_t)(tok0 + 32 * r + crow(reg, hh)) * 384 + h * 64 + 32 * c + l31] = f2bf(o[r][reg]);
    }
    __syncthreads();
  }
}

template <int NC, bool NOMAX>
DI void attn_item(const Params& p, int l, int b, int head, int qb, int isctx, char* smem) {
  const int tid = get_tid(), wave = tid >> 6, lane = tid & 63, l31 = lane & 31, hh = lane >> 5;
  constexpr int KS = 72, VS = 68;
  bf16* Ks = (bf16*)smem;
  bf16* Vs = Ks + 2 * 64 * KS;
  const int kvh = NC == 1 ? head / 3 : head;
  const int qcol0 = NC == 1 ? 768 + head * 64 : head * 64;
  const int kcol0 = NC == 1 ? 1152 + kvh * 64 : 256 + head * 64;
  const int ocol0 = NC == 1 ? 256 + head * 64 : head * 64;
  const bf16* Vt = NC == 1 ? p.VtG + (size_t)(b * 2 + kvh) * 64 * NKEY : p.VtD + (size_t)(b * 4 + head) * 64 * NKEY;
  const int tokq0 = isctx ? NLAT + b * CTXL + qb * 128 : b * SEQ + qb * 128;
  const int nkt = isctx ? 4 : 68;
  bf16x8 qf[4];
  {
    const bf16* qp = p.projA + (size_t)(tokq0 + wave * 32 + l31) * PA + qcol0 + 8 * hh;
#pragma unroll
    for (int s = 0; s < 4; ++s) qf[s] = *reinterpret_cast<const bf16x8*>(qp + 16 * s);
  }
  u32x4 rk[2], rv[2];
  auto gload = [&](int kt) {
    const int ktok0 = kt < 4 ? NLAT + b * CTXL + kt * 64 : b * SEQ + (kt - 4) * 64;
#pragma unroll
    for (int ii = 0; ii < 2; ++ii) {
      const int cidx = tid + ii * 256, row = cidx >> 3, cc = cidx & 7;
      rk[ii] = *reinterpret_cast<const u32x4*>(p.projA + (size_t)(ktok0 + row) * PA + kcol0 + cc * 8);
      rv[ii] = *reinterpret_cast<const u32x4*>(Vt + (size_t)row * NKEY + kt * 64 + cc * 8);
    }
  };
  auto lstore = [&](int buf) {
#pragma unroll
    for (int ii = 0; ii < 2; ++ii) {
      const int cidx = tid + ii * 256, row = cidx >> 3, cc = cidx & 7;
      *reinterpret_cast<u32x4*>(Ks + (buf * 64 + row) * KS + cc * 8) = rk[ii];
      u32x2 lo = {rv[ii][0], rv[ii][1]}, hi = {rv[ii][2], rv[ii][3]};
      *reinterpret_cast<u32x2*>(Vs + (buf * 64 + row) * VS + cc * 8) = lo;
      *reinterpret_cast<u32x2*>(Vs + (buf * 64 + row) * VS + cc * 8 + 4) = hi;
    }
  };
  f32x16 O[NC][2];
  float mrun[NC], lrun[NC];
#pragma unroll
  for (int c = 0; c < NC; ++c) { O[c][0] = zero16(); O[c][1] = zero16(); mrun[c] = -1e30f; lrun[c] = 0.f; }
  gload(0);
  lstore(0);
  __syncthreads();
  auto tile_body = [&](int kt) {
    const int buf = kt & 1;
    if (kt + 1 < nkt) gload(kt + 1);
    bf16x8 pf[NC][2][2];
#pragma unroll
    for (int c = 0; c < NC; ++c) {
      f32x16 S[2];
#pragma unroll
      for (int sub = 0; sub < 2; ++sub) {
        S[sub] = zero16();
        const bf16* kp = Ks + (buf * 64 + 32 * sub + l31) * KS + 8 * hh;
        if (NC == 2) {
#pragma unroll
          for (int s = 0; s < 2; ++s) S[sub] = mfma32(ldfrag(kp + 32 * c + 16 * s), qf[2 * c + s], S[sub]);
        } else {
#pragma unroll
          for (int s = 0; s < 4; ++s) S[sub] = mfma32(ldfrag(kp + 16 * s), qf[s], S[sub]);
        }
      }
      if (NOMAX) {
        float ls = 0.f;
#pragma unroll
        for (int sub = 0; sub < 2; ++sub)
#pragma unroll
          for (int r = 0; r < 16; ++r) { float e = ex2(S[sub][r]); S[sub][r] = e; ls += e; }
        lrun[c] += ls;
      } else {
        float mx = S[0][0];
#pragma unroll
        for (int r = 0; r < 16; ++r) { mx = fmaxf(mx, S[0][r]); mx = fmaxf(mx, S[1][r]); }
        mx = fmaxf(mx, __shfl_xor(mx, 32));
        const float mnew = fmaxf(mrun[c], mx);
        const float alpha = ex2(mrun[c] - mnew);
        mrun[c] = mnew;
        float ls = 0.f;
#pragma unroll
        for (int sub = 0; sub < 2; ++sub)
#pragma unroll
          for (int r = 0; r < 16; ++r) { float e = ex2(S[sub][r] - mnew); S[sub][r] = e; ls += e; }
        lrun[c] = lrun[c] * alpha + ls;
#pragma unroll
        for (int r = 0; r < 16; ++r) { O[c][0][r] *= alpha; O[c][1][r] *= alpha; }
      }
#pragma unroll
      for (int sub = 0; sub < 2; ++sub)
#pragma unroll
        for (int s2 = 0; s2 < 2; ++s2) pf[c][sub][s2] = pack_step(S[sub], s2);
    }
#pragma unroll
    for (int sub = 0; sub < 2; ++sub)
#pragma unroll
      for (int s2 = 0; s2 < 2; ++s2) {
        const int k0 = 32 * sub + 16 * s2 + 4 * hh;
        bf16x8 v0 = ldfrag_perm(Vs + (buf * 64 + l31) * VS, k0);
        bf16x8 v1 = ldfrag_perm(Vs + (buf * 64 + 32 + l31) * VS, k0);
#pragma unroll
        for (int c = 0; c < NC; ++c) {
          O[c][0] = mfma32(v0, pf[c][sub][s2], O[c][0]);
          O[c][1] = mfma32(v1, pf[c][sub][s2], O[c][1]);
        }
      }
    __builtin_amdgcn_sched_barrier(0);
    if (kt + 1 < nkt) lstore(buf ^ 1);
    __syncthreads();
  };
  if (NC == 2) {
#pragma unroll 1
    for (int kt = 0; kt < nkt; ++kt) tile_body(kt);
  } else {
    for (int kt = 0; kt < nkt; ++kt) tile_body(kt);
  }
  const int tid2 = get_tid(), hh2 = (tid2 >> 5) & 1;
  const int tok = tokq0 + (tid2 >> 6) * 32 + (tid2 & 31);
  bf16* op = p.abuf;
  if (NC == 1) {
    const float inv = 1.f / (lrun[0] + __shfl_xor(lrun[0], 32));
#pragma unroll
    for (int dvt = 0; dvt < 2; ++dvt)
#pragma unroll
      for (int g = 0; g < 4; ++g) {
        u32x2 w = {pack2(O[0][dvt][4 * g] * inv, O[0][dvt][4 * g + 1] * inv), pack2(O[0][dvt][4 * g + 2] * inv, O[0][dvt][4 * g + 3] * inv)};
        *reinterpret_cast<u32x2*>(op + a_off(tok, ocol0 + 32 * dvt + 8 * g + 4 * hh2, D)) = w;
      }
  } else {
    const float* lf = p.diff_lambda + l * 128;
    float s01 = 0.f, s23 = 0.f;
    for (int i = 0; i < 32; ++i) { s01 += lf[i] * lf[32 + i]; s23 += lf[64 + i] * lf[96 + i]; }
    const float lam_init = 0.8f - 0.6f * __expf(-0.3f * (float)l);
    const float lam = __expf(s01) - __expf(s23) + lam_init;
    const float inv0 = 1.f / (lrun[0] + __shfl_xor(lrun[0], 32));
    const float inv1 = lam / (lrun[NC - 1] + __shfl_xor(lrun[NC - 1], 32));
    float ss = 0.f;
#pragma unroll
    for (int dvt = 0; dvt < 2; ++dvt)
#pragma unroll
      for (int r = 0; r < 16; ++r) { float v = O[0][dvt][r] * inv0 - O[NC - 1][dvt][r] * inv1; O[0][dvt][r] = v; ss += v * v; }
    ss += __shfl_xor(ss, 32);
    const float rs = rsqrtf(ss * (1.f / 64.f) + 1e-6f) * (1.f - lam_init);
    const float* gn = p.diff_norm_g + l * 64;
#pragma unroll
    for (int dvt = 0; dvt < 2; ++dvt)
#pragma unroll
      for (int g = 0; g < 4; ++g) {
        const int dv0 = 32 * dvt + 8 * g + 4 * hh2;
        u32x2 w = {pack2(O[0][dvt][4 * g] * rs * gn[dv0], O[0][dvt][4 * g + 1] * rs * gn[dv0 + 1]),
                   pack2(O[0][dvt][4 * g + 2] * rs * gn[dv0 + 2], O[0][dvt][4 * g + 3] * rs * gn[dv0 + 3])};
        *reinterpret_cast<u32x2*>(op + a_off(tok, ocol0 + dv0, D)) = w;
      }
  }
}

DI void readout_phase(const Params& p, int l, int M) {
  const int total = M * 6;
  for (int u = get_bid() * NTHREADS + get_tid(); u < total; u += gridDim.x * NTHREADS) {
    const int tok = u / 6, h = u % 6;
    const u32x4* of = reinterpret_cast<const u32x4*>(p.Ob + (size_t)tok * 384 + h * 64);
    const u32x4* ob = reinterpret_cast<const u32x4*>(p.Ob + ((size_t)NTOK + tok) * 384 + h * 64);
    const u32x4* zp = reinterpret_cast<const u32x4*>(p.projZ + (size_t)tok * PZ + h * 64);
    bf16* op = p.abuf;
    const float* g = p.gdn_norm_g + l * 64;
    float x[64];
    float ss = 0.f;
#pragma unroll
    for (int i = 0; i < 8; ++i) {
      u32x4 a = of[i], c = ob[i];
#pragma unroll
      for (int j = 0; j < 4; ++j) {
        float v0 = bflo(a[j]) + bflo(c[j]), v1 = bfhi(a[j]) + bfhi(c[j]);
        x[i * 8 + 2 * j] = v0; x[i * 8 + 2 * j + 1] = v1; ss += v0 * v0 + v1 * v1;
      }
    }
    const float r = rsqrtf(ss * (1.f / 64.f) + 1e-6f);
#pragma unroll
    for (int i = 0; i < 8; ++i) {
      u32x4 z = zp[i], w;
#pragma unroll
      for (int j = 0; j < 4; ++j) {
        float y0 = x[i * 8 + 2 * j] * r * g[i * 8 + 2 * j] * silu_f(bflo(z[j]));
        float y1 = x[i * 8 + 2 * j + 1] * r * g[i * 8 + 2 * j + 1] * silu_f(bfhi(z[j]));
        w[j] = pack2(y0, y1);
      }
      *reinterpret_cast<u32x4*>(op + a_off(tok, 640 + h * 64 + 8 * i, D)) = w;
    }
  }
}

DI void final_phase(const Params& p) {
  const int tid = get_tid(), wave = tid >> 6, lane = tid & 63;
  for (int tok0 = get_bid() * 8 + wave * 2; tok0 < NLAT; tok0 += gridDim.x * 8) {
    float4 v[2][4];
    float ss[2] = {0.f, 0.f};
#pragma unroll
    for (int rr = 0; rr < 2; ++rr)
#pragma unroll
      for (int i = 0; i < 4; ++i) v[rr][i] = *reinterpret_cast<const float4*>(p.out + (size_t)(tok0 + rr) * D + i * 256 + lane * 4);
#pragma unroll
    for (int rr = 0; rr < 2; ++rr)
#pragma unroll
      for (int i = 0; i < 4; ++i) ss[rr] += v[rr][i].x * v[rr][i].x + v[rr][i].y * v[rr][i].y + v[rr][i].z * v[rr][i].z + v[rr][i].w * v[rr][i].w;
#pragma unroll
    for (int o = 32; o >= 1; o >>= 1) { ss[0] += __shfl_xor(ss[0], o); ss[1] += __shfl_xor(ss[1], o); }
#pragma unroll
    for (int rr = 0; rr < 2; ++rr) {
      const float rstd = rsqrtf(ss[rr] * (1.f / D) + 1e-6f);
#pragma unroll
      for (int i = 0; i < 4; ++i) {
        int col = i * 256 + lane * 4;
        float4 gg = *reinterpret_cast<const float4*>(p.final_norm_g + col);
        float4 o = {v[rr][i].x * rstd * gg.x, v[rr][i].y * rstd * gg.y, v[rr][i].z * rstd * gg.z, v[rr][i].w * rstd * gg.w};
        *reinterpret_cast<float4*>(p.out + (size_t)(tok0 + rr) * D + col) = o;
      }
    }
  }
}

DI void phaseC(const Params& p, int l, char* smem, bool skip_hv = false) {
  constexpr int N_GDN = 544 * 6, N_VT = 544 * 6;
  constexpr int N_HV = (NTOK * 16) / NTHREADS;
  const int total = N_GDN + N_VT + N_HV;
  for (int it = get_bid(); it < total; it += gridDim.x) {
    if (it < N_GDN) gdn_local_item(p, l, it, smem);
    else if (it < N_GDN + N_VT) vtrans_item(p, it - N_GDN, smem);
    else if (!skip_hv) headvec_unit(p, l, (it - N_GDN - N_VT) * NTHREADS + get_tid(), it - N_GDN - N_VT);
  }
}

DI void phaseD(const Params& p, int l, char* smem, int ci) {
  __shared__ int s_item;
  const int b = get_bid() & 7;
  const int n_scan = 12, n_diff = 4 * 32, n_gqa = 6 * 32;
  const int n_cd = l == 0 ? 4 * 2 : 0, n_cg = l == 0 ? 6 * 2 : 0;
  const int total = n_scan + n_diff + n_gqa + n_cd + n_cg;
  float gqm = 0.f, gkm = 0.f;
  for (int i = 0; i < 64; ++i) { gqm = fmaxf(gqm, fabsf(p.q_norm_g[l * 64 + i])); gkm = fmaxf(gkm, fabsf(p.k_norm_g[l * 64 + i])); }
  const bool fast_g = 64.f * 0.125f * LOG2E * gqm * gkm * 1.02f < 100.f;
  __shared__ float s_red[8];
  bool fast_d;
  {
    const int tid = get_tid();
    const float* st = p.stat + (size_t)l * 8704 * 2;
    float mq = 0.f, mk = 0.f;
    for (int i = tid; i < 8704; i += NTHREADS) { mq = fmaxf(mq, st[2 * i]); mk = fmaxf(mk, st[2 * i + 1]); }
#pragma unroll
    for (int o = 32; o >= 1; o >>= 1) { mq = fmaxf(mq, __shfl_xor(mq, o)); mk = fmaxf(mk, __shfl_xor(mk, o)); }
    __syncthreads();
    if ((tid & 63) == 0) { s_red[(tid >> 6) * 2] = mq; s_red[(tid >> 6) * 2 + 1] = mk; }
    __syncthreads();
    mq = fmaxf(fmaxf(s_red[0], s_red[2]), fmaxf(s_red[4], s_red[6]));
    mk = fmaxf(fmaxf(s_red[1], s_red[3]), fmaxf(s_red[5], s_red[7]));
    fast_d = sqrtf(mq * mk) * 1.02f < 100.f;
  }
  for (;;) {
    __syncthreads();
    if (get_tid() == 0) s_item = atomicAdd(&p.cnt[ci * 8 + b], 1);
    __syncthreads();
    int it = s_item;
    if (it >= total) break;
    if (it < n_scan) { gdn_scan_item(p, b * 12 + it, smem); continue; }
    it -= n_scan;
    if (it < n_diff) { if (fast_d) attn_item<2, true>(p, l, b, it >> 5, it & 31, 0, smem); else attn_item<2, false>(p, l, b, it >> 5, it & 31, 0, smem); continue; }
    it -= n_diff;
    if (it < n_gqa) { if (fast_g) attn_item<1, true>(p, l, b, it >> 5, it & 31, 0, smem); else attn_item<1, false>(p, l, b, it >> 5, it & 31, 0, smem); continue; }
    it -= n_gqa;
    if (it < n_cd) { if (fast_d) attn_item<2, true>(p, l, b, it >> 1, it & 1, 1, smem); else attn_item<2, false>(p, l, b, it >> 1, it & 1, 1, smem); continue; }
    it -= n_cd;
    if (fast_g) attn_item<1, true>(p, l, b, it >> 1, it & 1, 1, smem); else attn_item<1, false>(p, l, b, it >> 1, it & 1, 1, smem);
  }
}

__global__ void __launch_bounds__(NTHREADS, 2) mega_kernel(Params p) {
  __shared__ __attribute__((aligned(16))) char smem[SMEM_BYTES];
  cg::grid_group grid = cg::this_grid();
  unsigned* bar = reinterpret_cast<unsigned*>(p.cnt) + 64;
  __shared__ unsigned xb_state[4];
  volatile unsigned* xst = xb_state;
  if (threadIdx.x == 0) { xb_state[0] = 0u; xb_state[1] = 0u; xb_add(&bar[XB_XCNT(xb_xcc_id())], 1u); }
  phase0(p, smem);
  if (p.never) grid.sync();
  grid_barrier(bar, xst);
#pragma unroll 1
  for (int l = 0; l < 2; ++l) {
    const float* hlat = l == 0 ? p.x : p.out;
    const float* hctx = l == 0 ? p.ctx : p.hctx;
    const float* modl = p.mod + (size_t)l * 9 * 6144;
    const int Mfull = NTOK;
    const int Mout = l == 0 ? NTOK : NLAT;
    EpiArgs ea{};
    prep_phase(p, hlat, hctx, p.norm1_g + l * D, modl, 0, 1, Mfull);
    grid_barrier(bar, xst);
    gemm_phase<EPI_PROJ>(p, p.abuf, D, p.WinT + (size_t)l * IN_PAD * D, Mfull, IN_PAD, D, ea, smem);
    grid_barrier(bar, xst);
#if PROBE == 1
    gemm_phase<EPI_PROJ>(p, p.abuf, D, p.WinT + (size_t)l * IN_PAD * D, Mfull, IN_PAD, D, ea, smem);
    grid_barrier(bar, xst);
#endif
#if PROBE == 3
    phaseC(p, l, smem, true);
    grid_barrier(bar, xst);
#endif
    phaseC(p, l, smem);
    grid_barrier(bar, xst);
#if PROBE == 2
    phaseD(p, l, smem, l + 2);
    grid_barrier(bar, xst);
#endif
    phaseD(p, l, smem, l);
    grid_barrier(bar, xst);
    readout_phase(p, l, Mout);
    grid_barrier(bar, xst);
    ea.hin_lat = hlat; ea.hin_ctx = hctx; ea.hout_lat = p.out; ea.hout_ctx = p.hctx; ea.gate = modl + 2 * 1024;
    gemm_phase<EPI_RES>(p, p.abuf, D, p.WoutT + (size_t)l * D * D, Mout, D, D, ea, smem);
    grid_barrier(bar, xst);
    prep_phase(p, p.out, p.hctx, p.norm2_g + l * D, modl, 3, 4, Mout);
    grid_barrier(bar, xst);
    gemm_phase<EPI_SWIGLU>(p, p.abuf, D, p.WguT + (size_t)l * 2 * FFN * D, Mout, 2 * FFN, D, ea, smem);
    grid_barrier(bar, xst);
#if PROBE == 1
    gemm_phase<EPI_SWIGLU>(p, p.abuf, D, p.WguT + (size_t)l * 2 * FFN * D, Mout, 2 * FFN, D, ea, smem);
    grid_barrier(bar, xst);
#endif
    ea.hin_lat = p.out; ea.hin_ctx = p.hctx; ea.gate = modl + 5 * 1024;
    gemm_phase<EPI_RES>(p, p.projA, FFN, p.WdT + (size_t)l * D * FFN, Mout, D, FFN, ea, smem);
    grid_barrier(bar, xst);
  }
  final_phase(p);
}

extern "C" void kernel_launch(void* const* d_in, const int* in_sizes, int n_in, void* d_out, int out_size, void* d_ws, size_t ws_size,
                              hipStream_t stream) {
  (void)in_sizes; (void)n_in; (void)out_size;
  Params p{};
  const float* const* in = reinterpret_cast<const float* const*>(d_in);
  p.x = in[0]; p.c = in[1]; p.ctx = in[2]; p.c_ctx = in[3]; p.norm1_g = in[4]; p.ada_w = in[5]; p.ada_b = in[6]; p.w_in = in[7];
  p.diff_lambda = in[8]; p.diff_norm_g = in[9]; p.q_norm_g = in[10]; p.k_norm_g = in[11]; p.gdn_conv_w = in[12]; p.gdn_a_log = in[13];
  p.gdn_dt_bias = in[14]; p.gdn_norm_g = in[15]; p.w_out = in[16]; p.norm2_g = in[17]; p.ffn_w_gu = in[18]; p.ffn_w_down = in[19];
  p.final_norm_g = in[20];
  p.out = (float*)d_out;
  char* w = (char*)d_ws;
  size_t off = 0;
  auto take = [&](size_t bytes) { char* r = w + off; off += (bytes + 255) & ~(size_t)255; return r; };
  p.WinT = (bf16*)take((size_t)2 * IN_PAD * D * 2);
  p.WoutT = (bf16*)take((size_t)2 * D * D * 2);
  p.WguT = (bf16*)take((size_t)2 * 2 * FFN * D * 2);
  p.WdT = (bf16*)take((size_t)2 * D * FFN * 2);
  p.mod = (float*)take((size_t)2 * 9 * 6144 * 4);
  p.tabD = (float*)take(64 * 8 * 2 * 4);
  p.tabG = (float*)take(64 * 16 * 2 * 4);
  p.cnt = (int*)take(256 + XB_WORDS * 4);
  p.hctx = (float*)take((size_t)NCTX * D * 4);
  p.abuf = (bf16*)take((size_t)NTOK * D * 2);
  p.projA = (bf16*)take((size_t)NTOK * PA * 2);
  p.projG = (bf16*)take((size_t)NTOK * PG * 2);
  p.projZ = (bf16*)take((size_t)NTOK * PZ * 2);
  p.ab = (float*)take((size_t)NTOK * 24 * 4);
  p.VtD = (bf16*)take((size_t)NB * 4 * 64 * NKEY * 2);
  p.VtG = (bf16*)take((size_t)NB * 2 * 64 * NKEY * 2);
  p.gq = (bf16*)take((size_t)NTOK * 384 * 2);
  p.gk = (bf16*)take((size_t)NTOK * 384 * 2);
  p.U = (bf16*)take((size_t)2 * NTOK * 384 * 2);
  p.W = (bf16*)take((size_t)2 * NTOK * 384 * 2);
  p.G = (float*)take((size_t)2 * NTOK * 6 * 4);
  p.stat = (float*)take((size_t)2 * 8704 * 2 * 4);
  p.Ob = p.projG;
  if (off > ws_size) { fprintf(stderr, "workspace too small: need %zu have %zu\n", off, ws_size); return; }
  static int grid_blocks = 0;
  if (!grid_blocks) {
    int dev = 0, cus = 0, per_cu = 0;
    hipGetDevice(&dev);
    hipDeviceGetAttribute(&cus, hipDeviceAttributeMultiprocessorCount, dev);
    hipOccupancyMaxActiveBlocksPerMultiprocessor(&per_cu, mega_kernel, NTHREADS, 0);
    if (per_cu > 2) per_cu = 2;
    if (per_cu < 1) per_cu = 1;
    grid_blocks = cus * per_cu;
  }
  hipMemsetAsync(p.cnt, 0, 256 + XB_WORDS * 4, stream);
  void* args[] = {&p};
  hipError_t e = hipLaunchCooperativeKernel((void*)mega_kernel, dim3(grid_blocks), dim3(NTHREADS), args, 0, stream);
  if (e != hipSuccess) fprintf(stderr, "cooperative launch failed: %s (grid %d)\n", hipGetErrorString(e), grid_blocks);
}
```
